# Optimizing an MI355X kernel written in HIP

```python
import math
import jax, jax.numpy as jnp
from jax import lax
import numpy as np

D_MODEL = 1024
BATCH = 32
SEQ = 256
DEPTH = 1
DEC_BATCH = 4
DEC_SEQ = 1024
PAST_LEN = 512

GRID_W = 64
CHUNK = 128
N_RET_HEADS = 4
RET_DK = D_MODEL // 8
RET_DV = D_MODEL // 4
RET_QK = N_RET_HEADS * RET_DK
RET_V = N_RET_HEADS * RET_DV
N_SG_GROUPS = 4
SG_WIDTH = D_MODEL
SG_GROUP = SG_WIDTH // N_SG_GROUPS
D_FF = ((8 * D_MODEL // 3 + 127) // 128) * 128
N_MOD = 9
ROPE_THETA = 10000.0
EPS = 1e-6
IN_SIZES = (RET_QK, RET_QK, RET_V, RET_V, SG_WIDTH, SG_WIDTH, 2 * D_MODEL)
IN_WIDTH = sum(IN_SIZES)
IN_SPLITS = tuple(int(s) for s in np.cumsum(IN_SIZES)[:-1])

kernel_name = "hybrid_retention_gmlp_diffusion_step"


def _rms(x, g):
    xf = x.astype(jnp.float32)
    y = xf * lax.rsqrt(jnp.mean(xf * xf, axis=-1, keepdims=True) + EPS)
    return (y * g.astype(jnp.float32)).astype(x.dtype)


def _swiglu(h, w1, w2):
    a, b = jnp.split(h @ w1, 2, axis=-1)
    return (jax.nn.silu(a) * b) @ w2


def _axial_rope(L):
    rows = L // GRID_W
    r = jnp.repeat(jnp.arange(rows), GRID_W).astype(jnp.float32)
    col = (jnp.arange(rows * GRID_W) % GRID_W).astype(jnp.float32)
    nf = RET_DK // 4
    freqs = ROPE_THETA ** (-jnp.arange(nf, dtype=jnp.float32) / nf)
    ang = jnp.concatenate([r[:, None] * freqs, col[:, None] * freqs], axis=-1)
    return jnp.cos(ang), jnp.sin(ang)


def _apply_rope(x, cos, sin):
    half = RET_DK // 2
    x1, x2 = x[..., :half], x[..., half:]
    return jnp.concatenate([x1 * cos - x2 * sin, x1 * sin + x2 * cos], axis=-1)


def _retention_chunkwise(q, k, v, log_g, S0):
    B, H, L, _ = q.shape
    n = L // CHUNK
    idx = jnp.arange(CHUNK, dtype=jnp.float32)
    diff = idx[:, None] - idx[None, :]
    causal = diff >= 0
    dmask = jnp.where(causal, jnp.exp(log_g[:, None, None] * jnp.where(causal, diff, 0.0)), 0.0)
    q_dec = jnp.exp(log_g[:, None] * (idx + 1.0))[..., None]
    k_dec = jnp.exp(log_g[:, None] * (CHUNK - 1.0 - idx))[..., None]
    chunk_dec = jnp.exp(log_g * CHUNK)[:, None, None]

    def to_chunks(t):
        return t.reshape(B, H, n, CHUNK, t.shape[-1]).transpose(2, 0, 1, 3, 4)

    def step(S, qkv):
        qc, kc, vc = qkv
        scores = jnp.einsum('bhid,bhjd->bhij', qc, kc) * dmask
        o = (jnp.einsum('bhij,bhje->bhie', scores, vc)
             + jnp.einsum('bhid,bhde->bhie', qc * q_dec, S))
        S = S * chunk_dec + jnp.einsum('bhjd,bhje->bhde', kc * k_dec, vc)
        return S, o

    S, o = lax.scan(step, S0, (to_chunks(q), to_chunks(k), to_chunks(v)))
    o = o.transpose(1, 2, 0, 3, 4).reshape(B, H, L, v.shape[-1])
    return o, S


def _mixer(h, rope, S0f, S0b, w_in, decay_logit, g_ret, w_ret_br, g_sg, b_sg, w_sp, b_sp, w_sg_br, w_out):
    B, L, _ = h.shape
    z = h @ w_in
    q, k, v, g, u, vs, gates = jnp.split(z, IN_SPLITS, axis=-1)

    def heads(t, d):
        return t.reshape(B, L, N_RET_HEADS, d).transpose(0, 2, 1, 3).astype(jnp.float32)
    qh = heads(q, RET_DK) * (RET_DK ** -0.5)
    kh = heads(k, RET_DK)
    vh = heads(v, RET_DV)
    if rope is not None:
        qh = _apply_rope(qh, *rope)
        kh = _apply_rope(kh, *rope)
    log_g = jax.nn.log_sigmoid(decay_logit.astype(jnp.float32))
    of, Sf = _retention_chunkwise(qh, kh, vh, log_g[0], S0f.astype(jnp.float32))
    flip = lambda t: jnp.flip(t, axis=2)
    ob, Sb = _retention_chunkwise(flip(qh), flip(kh), flip(vh), log_g[1], S0b.astype(jnp.float32))
    r = of + flip(ob)
    mu = jnp.mean(r, axis=-1, keepdims=True)
    rc = r - mu
    r = rc * lax.rsqrt(jnp.mean(rc * rc, axis=-1, keepdims=True) + EPS)
    r = r.transpose(0, 2, 1, 3).reshape(B, L, RET_V) * g_ret.astype(jnp.float32)
    ret_out = (jax.nn.silu(g.astype(jnp.float32)) * r).astype(h.dtype) @ w_ret_br

    u = jax.nn.gelu(u)
    vsf = jax.nn.gelu(vs).astype(jnp.float32)
    vm = jnp.mean(vsf, axis=-1, keepdims=True)
    vc_ = vsf - vm
    vsn = vc_ * lax.rsqrt(jnp.mean(vc_ * vc_, axis=-1, keepdims=True) + EPS)
    vsn = (vsn * g_sg.astype(jnp.float32) + b_sg.astype(jnp.float32)).astype(h.dtype)
    n = L // CHUNK
    vsn = vsn.reshape(B, n, CHUNK, N_SG_GROUPS, SG_GROUP)
    sp = jnp.einsum('gij,bnjgc->bnigc', w_sp, vsn) + b_sp.T[:, :, None]
    sg_out = (u * sp.reshape(B, L, SG_WIDTH)) @ w_sg_br

    gate_r, gate_s = jnp.split(jax.nn.sigmoid(gates), 2, axis=-1)
    y = (gate_r * ret_out + gate_s * sg_out) @ w_out
    return y, Sf, Sb


def _layer(x, mod, rope, S0f, S0b, g_norm, w_ffn1_in, w_ffn1_out, w_in, decay_logit, g_ret, w_ret_br,
           g_sg, b_sg, w_sp, b_sp, w_sg_br, w_out, w_ffn2_in, w_ffn2_out):
    mo = lambda i: mod[:, i][:, None, :]
    hh = _rms(x, g_norm[0]) * (1 + mo(1)) + mo(0)
    x = x + 0.5 * mo(2) * _rms(_swiglu(hh, w_ffn1_in, w_ffn1_out), g_norm[1])
    hh = _rms(x, g_norm[2]) * (1 + mo(4)) + mo(3)
    y, Sf, Sb = _mixer(hh, rope, S0f, S0b, w_in, decay_logit, g_ret, w_ret_br, g_sg, b_sg, w_sp, b_sp, w_sg_br, w_out)
    x = x + mo(5) * _rms(y, g_norm[3])
    hh = _rms(x, g_norm[4]) * (1 + mo(7)) + mo(6)
    x = x + 0.5 * mo(8) * _rms(_swiglu(hh, w_ffn2_in, w_ffn2_out), g_norm[5])
    return x, Sf, Sb


def setup_inputs(seed: int = 0) -> dict:
    key = jax.random.key(seed)
    ks = jax.random.split(key, 24)
    nrm = lambda k, s, sc=1.0: jax.random.normal(k, s, jnp.float32) * sc
    D = D_MODEL
    base_logit = jnp.log(2.0 ** (5.0 + jnp.arange(N_RET_HEADS, dtype=jnp.float32)) - 1.0)
    return {
        "x_prompt": nrm(ks[0], (BATCH, SEQ, D)),
        "x_sample": nrm(ks[1], (DEC_BATCH, DEC_SEQ, D)),
        "state_ret_fwd": nrm(ks[2], (DEC_BATCH, DEPTH, N_RET_HEADS, RET_DK, RET_DV), 0.3),
        "state_ret_bwd": nrm(ks[3], (DEC_BATCH, DEPTH, N_RET_HEADS, RET_DK, RET_DV), 0.3),
        "c": nrm(ks[4], (DEC_BATCH, D)),
        "c_ctx": nrm(ks[5], (D,)),
        "w_ada": nrm(ks[6], (DEPTH, D, N_MOD * D), 0.3 * D ** -0.5),
        "b_ada": nrm(ks[7], (DEPTH, N_MOD * D), 0.1),
        "g_norm": 1.0 + nrm(ks[8], (DEPTH, 6, D), 0.1),
        "w_ffn1_in": nrm(ks[9], (DEPTH, D, 2 * D_FF), D ** -0.5),
        "w_ffn1_out": nrm(ks[10], (DEPTH, D_FF, D), D_FF ** -0.5),
        "w_in": nrm(ks[11], (DEPTH, D, IN_WIDTH), D ** -0.5),
        "ret_decay_logit": base_logit[None, None, :] + nrm(ks[12], (DEPTH, 2, N_RET_HEADS), 0.1),
        "g_ret": 1.0 + nrm(ks[13], (DEPTH, RET_V), 0.1),
        "w_ret_br": nrm(ks[14], (DEPTH, RET_V, D), RET_V ** -0.5),
        "g_sg": 1.0 + nrm(ks[15], (DEPTH, SG_WIDTH), 0.1),
        "b_sg": nrm(ks[16], (DEPTH, SG_WIDTH), 0.02),
        "w_sp": nrm(ks[17], (DEPTH, N_SG_GROUPS, CHUNK, CHUNK), CHUNK ** -0.5),
        "b_sp": 1.0 + nrm(ks[18], (DEPTH, N_SG_GROUPS, CHUNK), 0.1),
        "w_sg_br": nrm(ks[19], (DEPTH, SG_WIDTH, D), SG_WIDTH ** -0.5),
        "w_out": nrm(ks[20], (DEPTH, D, D), D ** -0.5),
        "w_ffn2_in": nrm(ks[21], (DEPTH, D, 2 * D_FF), D ** -0.5),
        "w_ffn2_out": nrm(ks[22], (DEPTH, D_FF, D), D_FF ** -0.5),
    }


def reference(x_prompt, x_sample, state_ret_fwd, state_ret_bwd, c, c_ctx, w_ada, b_ada, g_norm,
              w_ffn1_in, w_ffn1_out, w_in, ret_decay_logit, g_ret, w_ret_br, g_sg, b_sg, w_sp, b_sp,
              w_sg_br, w_out, w_ffn2_in, w_ffn2_out):
    yp = x_prompt
    ys = x_sample
    Bp = x_prompt.shape[0]
    Bs = x_sample.shape[0]
    rope = _axial_rope(x_sample.shape[1])
    zero_state = jnp.zeros((Bp, N_RET_HEADS, RET_DK, RET_DV), jnp.float32)
    new_f, new_b = [], []
    for l in range(DEPTH):
        lw = (g_norm[l], w_ffn1_in[l], w_ffn1_out[l], w_in[l], ret_decay_logit[l], g_ret[l], w_ret_br[l],
              g_sg[l], b_sg[l], w_sp[l], b_sp[l], w_sg_br[l], w_out[l], w_ffn2_in[l], w_ffn2_out[l])
        mod_ctx = (jax.nn.silu(c_ctx)[None, :] @ w_ada[l] + b_ada[l]).reshape(1, N_MOD, D_MODEL)
        mod_lat = (jax.nn.silu(c) @ w_ada[l] + b_ada[l]).reshape(Bs, N_MOD, D_MODEL)
        yp, Sf, Sb = _layer(yp, mod_ctx, None, zero_state, zero_state, *lw)
        new_f.append(Sf)
        new_b.append(Sb)
        ys, _, _ = _layer(ys, mod_lat, rope, state_ret_fwd[:, l], state_ret_bwd[:, l], *lw)
    new_state_ret_fwd = jnp.stack(new_f, axis=1).astype(x_prompt.dtype)
    new_state_ret_bwd = jnp.stack(new_b, axis=1).astype(x_prompt.dtype)
    return (yp, ys, new_state_ret_fwd, new_state_ret_bwd)
```

```cpp
#include <hip/hip_runtime.h>
#include <hip/hip_cooperative_groups.h>
#include <cstdio>
#include <cstdint>
namespace cg = cooperative_groups;

#define LAS __attribute__((address_space(3)))
typedef unsigned short bf16_t;
typedef short bf16x8 __attribute__((ext_vector_type(8)));
typedef float f32x4 __attribute__((ext_vector_type(4)));
typedef float f32x2 __attribute__((ext_vector_type(2)));
typedef unsigned u32x4 __attribute__((ext_vector_type(4)));
typedef unsigned u32x2 __attribute__((ext_vector_type(2)));

constexpr int D = 1024, MP = 8192, MS = 4096, M = 12288, FF = 2816, NMOD = 9;
constexpr float EPS = 1e-6f;
constexpr size_t MiB = 1u << 20, KiB = 1u << 10;
constexpr size_t WS_WR = 0, WS_WS = 2 * MiB, WS_WO = 4 * MiB, WS_BD = 6 * MiB, WS_MOD = 6 * MiB + 512 * KiB, WS_ROPE = 7 * MiB, WS_LG = 6 * MiB + 768 * KiB, WS_BAR = 6 * MiB + 832 * KiB, WS_CNT = WS_BAR + 16 * KiB, WS_XS = 7 * MiB + 512 * KiB;
constexpr size_t WS_W1 = 8 * MiB, WS_W2 = 19 * MiB, WS_WIN = 24 * MiB + 512 * KiB, WS_H = 38 * MiB + 512 * KiB;
constexpr size_t WS_PP = 8 * MiB, WS_PS = 24 * MiB;
constexpr size_t WS_W3 = 8 * MiB, WS_W4 = 19 * MiB, WS_H3 = 24 * MiB + 512 * KiB;
constexpr int LD_VTP = MP + 64, LD_KT = MP + 64, LD_GVT = M + 64;
constexpr size_t WS_Q = 64 * MiB, WS_K = 76 * MiB, WS_VTP = 88 * MiB, WS_VTS = 105 * MiB, WS_KT = 115 * MiB, WS_G = 132 * MiB, WS_U = 156 * MiB,
                 WS_GVT = 180 * MiB, WS_GATES = 205 * MiB;
constexpr size_t WS_ACT = 64 * MiB, WS_F = 130 * MiB, WS_TMP = 64 * MiB, WS_MERGED = 180 * MiB, WS_Y = 132 * MiB, WS_END = 253 * MiB;
static_assert((size_t)1024 * LD_VTP * 2 <= 17 * MiB && (size_t)1024 * LD_GVT * 2 <= 25 * MiB, "padded buffers fit");
constexpr size_t OUT_H2 = (size_t)M * D * 4, OUT_WKV = OUT_H2 + 24 * MiB;
constexpr int LDS_BYTES = 147456, XL_OFF = 131072, MISC_OFF = 131072 + 8192;

struct Params {
    const float* x_prompt; const float* x_sample; const float* s0f; const float* s0b; const float* c; const float* c_ctx;
    const float* w_ada; const float* b_ada; const float* g_norm; const float* w_ffn1_in; const float* w_ffn1_out; const float* w_in;
    const float* decay; const float* g_ret; const float* w_ret_br; const float* g_sg; const float* b_sg; const float* w_sp; const float* b_sp;
    const float* w_sg_br; const float* w_out; const float* w_ffn2_in; const float* w_ffn2_out;
    float* out; unsigned char* ws; int ph_lo, ph_hi;
};

typedef __bf16 bf16x2_t __attribute__((ext_vector_type(2)));
__device__ __forceinline__ unsigned cvt_pk_bf16(float lo, float hi) { const f32x2 v = {lo, hi}; const bf16x2_t b = __builtin_convertvector(v, bf16x2_t); return __builtin_bit_cast(unsigned, b); }
__device__ __forceinline__ u32x4 pack8(f32x4 a, f32x4 b) { u32x4 w; w.x = cvt_pk_bf16(a[0], a[1]); w.y = cvt_pk_bf16(a[2], a[3]); w.z = cvt_pk_bf16(b[0], b[1]); w.w = cvt_pk_bf16(b[2], b[3]); return w; }
__device__ __forceinline__ void unpack8(u32x4 w, f32x4& a, f32x4& b) {
    a[0] = __uint_as_float(w.x << 16); a[1] = __uint_as_float(w.x & 0xffff0000u); a[2] = __uint_as_float(w.y << 16); a[3] = __uint_as_float(w.y & 0xffff0000u);
    b[0] = __uint_as_float(w.z << 16); b[1] = __uint_as_float(w.z & 0xffff0000u); b[2] = __uint_as_float(w.w << 16); b[3] = __uint_as_float(w.w & 0xffff0000u);
}
__device__ __forceinline__ float fsigmoid(float x) { return __builtin_amdgcn_rcpf(1.f + __builtin_amdgcn_exp2f(-1.44269504f * x)); }
__device__ __forceinline__ float fsilu(float x) { return x * fsigmoid(x); }
__device__ __forceinline__ float fgelu(float x) { const float z = 0.7978845608f * (x + 0.044715f * x * x * x); return x * fsigmoid(2.f * z); }
__device__ __forceinline__ f32x4 silu4(f32x4 v) { return (f32x4){fsilu(v[0]), fsilu(v[1]), fsilu(v[2]), fsilu(v[3])}; }
__device__ __forceinline__ f32x4 gelu4(f32x4 v) { return (f32x4){fgelu(v[0]), fgelu(v[1]), fgelu(v[2]), fgelu(v[3])}; }
__device__ __forceinline__ f32x4 sigm4(f32x4 v) { return (f32x4){fsigmoid(v[0]), fsigmoid(v[1]), fsigmoid(v[2]), fsigmoid(v[3])}; }
__device__ __forceinline__ float wave_sum(float v) {
#pragma unroll
    for (int o = 1; o < 64; o <<= 1) v += __shfl_xor(v, o);
    return v;
}
__device__ __forceinline__ float lg2_decay_slow(const float* decay, int i) { const float x = decay[i]; return -log1pf(expf(-x)) * 1.44269504f; }
__device__ __forceinline__ float lg2_decay(const float* lgt, int dir, int h) { return lgt[dir * 4 + h]; }
#define LDS_WAIT() asm volatile("s_waitcnt lgkmcnt(0)" ::: "memory")
#define WG_BAR() do { asm volatile("s_waitcnt lgkmcnt(0)" ::: "memory"); __builtin_amdgcn_s_barrier(); asm volatile("" ::: "memory"); } while (0)

constexpr int HTB = 128 * 64 * 2;
__device__ __forceinline__ int lds_byte(int r, int c) { const int st = (r >> 4) * 2 + (c >> 5), rr = r & 15, cc = c & 31, ob = rr * 64 + cc * 2; return st * 1024 + (ob ^ (((ob >> 9) & 1) << 5)); }
__device__ __forceinline__ void stage_rc(int b, int& R, int& C) { const int st = b / 1024, sb = b % 1024, swz = sb ^ (((sb >> 9) & 1) << 5); R = (st >> 1) * 16 + swz / 64; C = (st & 1) * 32 + (swz % 64) / 2; }
__device__ __forceinline__ int perm32(int rho) { const int n = rho >> 4, i = rho & 15; return 8 * (i >> 2) + 4 * n + (i & 3); }

struct Unit { const char* a; const char* b; unsigned lda, ldb; int nt, kind, pm, pn, aux; };

__device__ __forceinline__ void tile_map(int idx, int nM, int nN, int& pm, int& pn) {
    const int nwg = nM * nN; int wgid = idx;
    { const int q = nwg / 8, r = nwg % 8, xcd = wgid % 8, off = wgid / 8; wgid = (xcd < r ? xcd * (q + 1) : r * (q + 1) + (xcd - r) * q) + off; }
    const int nig = 8 * nN, gid = wgid / nig, fm = gid * 8, gsz = (nM - fm) < 8 ? (nM - fm) : 8;
    pm = fm + ((wgid % nig) % gsz); pn = (wgid % nig) / gsz;
}

#define EPI_ARGS const f32x4 (&acc)[2][2][4][2], const Unit& u, int wr, int wc, int fr, int fq

constexpr int UNIT_HALF_KIND = 17;
template <class Epi, class Sched, bool HM2 = false, bool HC = false>
__device__ __forceinline__ void gemm_phase(LAS unsigned char* lds, const Sched& S, const Epi& E) {
    const int tid = threadIdx.x, wid = __builtin_amdgcn_readfirstlane(tid >> 6), lane = tid & 63, wr = wid >> 2, wc = wid & 3, fr = lane & 15, fq = lane >> 4;
    int RA, RB, C2;
    { int R, C; stage_rc(tid * 16, R, C); RA = R; RB = (R & ~31) + perm32(R & 31); C2 = C * 2; }
    const unsigned ldsw = (unsigned)wid * 1024u;
    const int aoff = lds_byte(wr * 64 + fr, fq * 8), boff = lds_byte(wc * 32 + fr, fq * 8);
#define PG8_SA(b, h) (((b) * 2 + (h)) * HTB)
#define PG8_SB(b, h) ((4 + (b) * 2 + (h)) * HTB)
#define PG8_STAGE(bufoff, gbase, RR, ld) do { const unsigned _vo = (unsigned)(RR * (int)(ld) + C2); _Pragma("unroll") for (int _i = 0; _i < 2; ++_i) { \
        const char* _gb = (const char*)(gbase) + (size_t)(_i * 64u * (ld)); asm volatile("" : "+s"(_gb)); \
        __builtin_amdgcn_global_load_lds((const unsigned*)(_gb + _vo), (LAS unsigned*)(lds + (bufoff) + ldsw + _i * 8192), 16, 0, 0); } } while (0)
#define PG8_STAGE_A1(bufoff, gbase, ld) do { if (HM2) { const unsigned _vo = (unsigned)((RA & 31) * (int)(ld) + C2); _Pragma("unroll") for (int _i = 0; _i < 2; ++_i) { \
        const char* _gb = (const char*)(gbase) + (size_t)(_i * 32u * (ld)); asm volatile("" : "+s"(_gb)); \
        __builtin_amdgcn_global_load_lds((const unsigned*)(_gb + _vo), (LAS unsigned*)(lds + (bufoff) + ldsw + _i * 8192), 16, 0, 0); } } else PG8_STAGE(bufoff, gbase, RA, ld); } while (0)
#define PG8_LDA1(dst, b) do { _Pragma("unroll") for (int m = 0; m < (HM2 ? 2 : 4); ++m) _Pragma("unroll") for (int k = 0; k < 2; ++k) dst[m][k] = *(const LAS bf16x8*)(lds + PG8_SA(b, 1) + aoff + m * 2048 + k * 1024); } while (0)
#define PG8_MMA1(bj, At, Bt) do { __builtin_amdgcn_s_setprio(1); _Pragma("unroll") for (int m = 0; m < (HM2 ? 2 : 4); ++m) _Pragma("unroll") for (int n = 0; n < 2; ++n) _Pragma("unroll") for (int k = 0; k < 2; ++k) \
        acc[1][bj][m][n] = __builtin_amdgcn_mfma_f32_16x16x32_bf16(Bt[n][k], At[m][k], acc[1][bj][m][n], 0, 0, 0); __builtin_amdgcn_s_setprio(0); } while (0)
#define PG8_LDA(dst, b, h) do { _Pragma("unroll") for (int m = 0; m < 4; ++m) _Pragma("unroll") for (int k = 0; k < 2; ++k) dst[m][k] = *(const LAS bf16x8*)(lds + PG8_SA(b, h) + aoff + m * 2048 + k * 1024); } while (0)
#define PG8_LDB(dst, b, h) do { _Pragma("unroll") for (int n = 0; n < 2; ++n) _Pragma("unroll") for (int k = 0; k < 2; ++k) dst[n][k] = *(const LAS bf16x8*)(lds + PG8_SB(b, h) + boff + n * 2048 + k * 1024); } while (0)
#define PG8_MMA(ai, bj, At, Bt) do { __builtin_amdgcn_s_setprio(1); _Pragma("unroll") for (int m = 0; m < 4; ++m) _Pragma("unroll") for (int n = 0; n < 2; ++n) _Pragma("unroll") for (int k = 0; k < 2; ++k) \
        acc[ai][bj][m][n] = __builtin_amdgcn_mfma_f32_16x16x32_bf16(Bt[n][k], At[m][k], acc[ai][bj][m][n], 0, 0, 0); __builtin_amdgcn_s_setprio(0); } while (0)
#define PG8_WAIT_V(n) asm volatile("s_waitcnt vmcnt(" #n ")" ::: "memory")
#define PG8_WAIT_L(n) asm volatile("s_waitcnt lgkmcnt(" #n ")" ::: "memory")
#define PG8_BAR __builtin_amdgcn_s_barrier()
#define PG8_SCHED __builtin_amdgcn_sched_barrier(0)
    Unit cur, nxt; int ui = 0;
    if (!S.next(0, cur)) return;
    f32x4 acc[2][2][4][2];
#pragma unroll
    for (int a = 0; a < 2; ++a)
#pragma unroll
        for (int b = 0; b < 2; ++b)
#pragma unroll
            for (int m = 0; m < 4; ++m)
#pragma unroll
                for (int n = 0; n < 2; ++n) acc[a][b][m][n] = (f32x4){0.f, 0.f, 0.f, 0.f};
    bf16x8 At[4][2], B0[2][2], B1[2][2];
    const char* cA = cur.a; const char* cB = cur.b; unsigned cla = cur.lda, clb = cur.ldb;
    PG8_STAGE(PG8_SB(0, 0), cB, RB, clb); PG8_STAGE(PG8_SB(0, 1), cB + 128u * clb, RB, clb); PG8_STAGE(PG8_SA(0, 0), cA, RA, cla); PG8_STAGE_A1(PG8_SA(0, 1), cA + 128u * cla, cla);
    if (wr == 1) PG8_BAR;
    PG8_WAIT_V(2); PG8_BAR;
    PG8_STAGE(PG8_SB(1, 0), cB + 128, RB, clb); PG8_STAGE(PG8_SA(1, 0), cA + 128, RA, cla); PG8_STAGE(PG8_SB(1, 1), cB + 128u * clb + 128, RB, clb);
    PG8_WAIT_V(6); PG8_BAR;
    for (;;) {
        const bool has_next = S.next(ui + 1, nxt);
        const char* nA = has_next ? nxt.a : cA; const char* nB = has_next ? nxt.b : cB;
        const unsigned nla = has_next ? nxt.lda : cla, nlb = has_next ? nxt.ldb : clb;
        const int nt = cur.nt; const bool halfu = HC && cur.kind == UNIT_HALF_KIND;
        for (int t = 0; t < nt; t += 2) {
            const bool last = (t == nt - 2);
            const char* a1 = cA + (size_t)(t + 1) * 128;
            const char* a2 = last ? nA : cA + (size_t)(t + 2) * 128; const char* b2 = last ? nB : cB + (size_t)(t + 2) * 128;
            const unsigned la2 = last ? nla : cla, lb2 = last ? nlb : clb;
            const char* a3 = a2 + 128; const char* b3 = b2 + 128;
            PG8_LDB(B0, 0, 0); PG8_LDB(B1, 0, 1); PG8_SCHED; PG8_LDA(At, 0, 0); PG8_STAGE_A1(PG8_SA(1, 1), a1 + 128u * cla, cla);
            PG8_WAIT_V(8); PG8_WAIT_L(0); PG8_BAR; PG8_MMA(0, 0, At, B0); PG8_MMA(0, 1, At, B1); PG8_BAR; PG8_SCHED;
            if (!halfu) PG8_LDA1(At, 0); PG8_STAGE(PG8_SB(0, 0), b2, RB, lb2); PG8_STAGE(PG8_SB(0, 1), b2 + 128u * lb2, RB, lb2); PG8_STAGE(PG8_SA(0, 0), a2, RA, la2);
            PG8_WAIT_V(8); PG8_WAIT_L(0); PG8_BAR; if (!halfu) { PG8_MMA1(0, At, B0); PG8_MMA1(1, At, B1); } PG8_BAR; PG8_SCHED;
            PG8_LDB(B0, 1, 0); PG8_LDB(B1, 1, 1); PG8_SCHED; PG8_LDA(At, 1, 0); PG8_STAGE_A1(PG8_SA(0, 1), a2 + 128u * la2, la2);
            PG8_WAIT_V(8); PG8_WAIT_L(0); PG8_BAR; PG8_MMA(0, 0, At, B0); PG8_MMA(0, 1, At, B1); PG8_BAR; PG8_SCHED;
            if (!halfu) PG8_LDA1(At, 1); PG8_STAGE(PG8_SB(1, 0), b3, RB, lb2); PG8_STAGE(PG8_SB(1, 1), b3 + 128u * lb2, RB, lb2); PG8_STAGE(PG8_SA(1, 0), a3, RA, la2);
            PG8_WAIT_V(8); PG8_WAIT_L(0); PG8_BAR; if (!halfu) { PG8_MMA1(0, At, B0); PG8_MMA1(1, At, B1); } PG8_BAR; PG8_SCHED;
        }
        if (wr == 0) PG8_BAR;
        E(acc, cur, wr, wc, fr, fq);
        if (!has_next) break;
#pragma unroll
        for (int a = 0; a < 2; ++a)
#pragma unroll
            for (int b = 0; b < 2; ++b)
#pragma unroll
                for (int m = 0; m < 4; ++m)
#pragma unroll
                    for (int n = 0; n < 2; ++n) acc[a][b][m][n] = (f32x4){0.f, 0.f, 0.f, 0.f};
        cur = nxt; cA = nA; cB = nB; cla = nla; clb = nlb; ++ui;
        if (wr == 1) PG8_BAR;
    }
    PG8_WAIT_V(0);
    PG8_BAR;
#undef PG8_SA
#undef PG8_SB
#undef PG8_STAGE
#undef PG8_LDA
#undef PG8_LDA1
#undef PG8_MMA1
#undef PG8_STAGE_A1
#undef PG8_LDB
#undef PG8_MMA
#undef PG8_WAIT_V
#undef PG8_WAIT_L
#undef PG8_BAR
#undef PG8_SCHED
}

enum Kind { K_SWIGLU = 0, K_F32, K_QK, K_G, K_U, K_GATES, K_VT, K_GVT, K_KT, K_SC_P, K_SC_S, K_PV_P, K_PV_S, K_STATE, K_SPATIAL, K_MERGE0, K_MERGE1, K_SWIGLU_H   };
static_assert(K_SWIGLU_H == UNIT_HALF_KIND, "kind id used by the engine");

__device__ __forceinline__ void epi_swiglu(EPI_ARGS, bf16_t* out) {
    const bool halfu = u.kind == K_SWIGLU_H;
    const int row0 = u.pm * 256 + (halfu ? u.aux : 0) + wr * 64 + fr, col0 = u.pn * 128 + wc * 32 + 8 * fq;
#pragma unroll
    for (int ai = 0; ai < 2; ++ai)
#pragma unroll
        for (int m = 0; m < 4; ++m) { if (ai == 1 && halfu) continue;
            const f32x4 o0 = silu4(acc[ai][0][m][0]) * acc[ai][1][m][0], o1 = silu4(acc[ai][0][m][1]) * acc[ai][1][m][1];
            *(u32x4*)(out + (size_t)(row0 + ai * 128 + m * 16) * FF + col0) = pack8(o0, o1);
        }
}
__device__ __forceinline__ void epi_f32(EPI_ARGS, bf16_t* out, int ld) {
    const int row0 = u.pm * 256 + wr * 64 + fr, col0 = u.pn * 256 + wc * 32 + 8 * fq;
#pragma unroll
    for (int ai = 0; ai < 2; ++ai)
#pragma unroll
        for (int m = 0; m < 4; ++m) { bf16_t* rp = out + (size_t)(row0 + ai * 128 + m * 16) * ld + col0;
#pragma unroll
            for (int bj = 0; bj < 2; ++bj) *(u32x4*)(rp + bj * 128) = pack8(acc[ai][bj][m][0], acc[ai][bj][m][1]); }
}
template <int ACT> __device__ __forceinline__ void epi_act(EPI_ARGS, bf16_t* out, int ld, int colbase) {
    const int row0 = u.pm * 256 + wr * 64 + fr, col0 = colbase + wc * 32 + 8 * fq;
#pragma unroll
    for (int ai = 0; ai < 2; ++ai)
#pragma unroll
        for (int m = 0; m < 4; ++m) { bf16_t* rp = out + (size_t)(row0 + ai * 128 + m * 16) * ld + col0;
#pragma unroll
            for (int bj = 0; bj < 2; ++bj) { f32x4 v0 = acc[ai][bj][m][0], v1 = acc[ai][bj][m][1];
                if (ACT == 0) { v0 = silu4(v0); v1 = silu4(v1); } else if (ACT == 1) { v0 = gelu4(v0); v1 = gelu4(v1); } else { v0 = sigm4(v0); v1 = sigm4(v1); }
                *(u32x4*)(rp + bj * 128) = pack8(v0, v1); } }
}
__device__ __forceinline__ void epi_qk(EPI_ARGS, bf16_t* dst, float scale, const float* rope) {
    const int hp = u.aux, o0 = wc * 32 + 8 * fq, head = hp * 2 + (o0 >> 6), p0 = o0 & 63;
    const bool do_rope = u.pm >= 32;
#pragma unroll
    for (int ai = 0; ai < 2; ++ai) {
        f32x4 cs[4][4];
        if (do_rope) {
#pragma unroll
            for (int m = 0; m < 4; ++m) { const int pos = (u.pm * 256 + ai * 128 + wr * 64 + m * 16 + fr - MP) & 1023; const f32x4* cp = (const f32x4*)(rope + ((size_t)pos * 64 + p0) * 2);
                cs[m][0] = cp[0]; cs[m][1] = cp[1]; cs[m][2] = cp[2]; cs[m][3] = cp[3]; } }
#pragma unroll
        for (int m = 0; m < 4; ++m) {
            const int row = u.pm * 256 + ai * 128 + wr * 64 + m * 16 + fr;
            f32x4 x1a = acc[ai][0][m][0] * scale, x1b = acc[ai][0][m][1] * scale, x2a = acc[ai][1][m][0] * scale, x2b = acc[ai][1][m][1] * scale;
            if (do_rope) {
                const f32x4 c0 = cs[m][0], c1 = cs[m][1], c2 = cs[m][2], c3 = cs[m][3];
                const f32x4 ca = (f32x4){c0[0], c0[2], c1[0], c1[2]}, sa = (f32x4){c0[1], c0[3], c1[1], c1[3]};
                const f32x4 cb = (f32x4){c2[0], c2[2], c3[0], c3[2]}, sb = (f32x4){c2[1], c2[3], c3[1], c3[3]};
                const f32x4 y1a = x1a * ca - x2a * sa, y2a = x1a * sa + x2a * ca, y1b = x1b * cb - x2b * sb, y2b = x1b * sb + x2b * cb;
                x1a = y1a; x2a = y2a; x1b = y1b; x2b = y2b;
            }
            bf16_t* rp = dst + (size_t)row * 512 + head * 128 + p0;
            *(u32x4*)rp = pack8(x1a, x1b); *(u32x4*)(rp + 64) = pack8(x2a, x2b);
        }
    }
}
__device__ __forceinline__ void epi_vt(EPI_ARGS, bf16_t* vtp, bf16_t* vts) {
    const int wt = u.pm, tt = u.pn, c0 = wc * 32 + 8 * fq;
#pragma unroll
    for (int ai = 0; ai < 2; ++ai)
#pragma unroll
        for (int m = 0; m < 4; ++m) { const int vrow = wt * 256 + ai * 128 + wr * 64 + m * 16 + fr;
            bf16_t* rp;
            if (tt < 32) rp = vtp + (size_t)vrow * LD_VTP + tt * 256 + c0;
            else { const int b = (tt - 32) >> 2, pos0 = ((tt - 32) & 3) * 256 + c0; rp = vts + ((size_t)b * 1024 + vrow) * 1280 + pos0; }
#pragma unroll
            for (int bj = 0; bj < 2; ++bj) *(u32x4*)(rp + bj * 128) = pack8(acc[ai][bj][m][0], acc[ai][bj][m][1]); }
}
__device__ __forceinline__ void epi_gvt(EPI_ARGS, bf16_t* gvt) {
    const int wt = u.pm - 4, tt = u.pn, c0 = wc * 32 + 8 * fq;
#pragma unroll
    for (int ai = 0; ai < 2; ++ai)
#pragma unroll
        for (int m = 0; m < 4; ++m) { const int ch = wt * 256 + ai * 128 + wr * 64 + m * 16 + fr; bf16_t* rp = gvt + (size_t)ch * LD_GVT + tt * 256 + c0;
#pragma unroll
            for (int bj = 0; bj < 2; ++bj) *(u32x4*)(rp + bj * 128) = pack8(gelu4(acc[ai][bj][m][0]), gelu4(acc[ai][bj][m][1])); }
}
__device__ __forceinline__ void epi_kt(EPI_ARGS, bf16_t* kt, const float* decay) {
    const int hp = u.pm, tt = u.pn, head = hp * 2 + wr, c0 = wc * 32 + 8 * fq;
    const float lf = lg2_decay(decay, 0, head), lb = lg2_decay(decay, 1, head);
    f32x4 wf[2][2], wb[2][2];
#pragma unroll
    for (int bj = 0; bj < 2; ++bj)
#pragma unroll
        for (int n = 0; n < 2; ++n)
#pragma unroll
            for (int j = 0; j < 4; ++j) { const float t = (float)(bj * 128 + c0 + 4 * n + j); wf[bj][n][j] = __builtin_amdgcn_exp2f(lf * (255.f - t)); wb[bj][n][j] = __builtin_amdgcn_exp2f(lb * t); }
#pragma unroll
    for (int ai = 0; ai < 2; ++ai)
#pragma unroll
        for (int m = 0; m < 4; ++m) { const int dim = ai * 64 + m * 16 + fr;
            bf16_t* rf = kt + ((size_t)((head * 2 + 0) * 128 + dim)) * LD_KT + tt * 256 + c0; bf16_t* rb = rf + (size_t)128 * LD_KT;
#pragma unroll
            for (int bj = 0; bj < 2; ++bj) {
                *(u32x4*)(rf + bj * 128) = pack8(acc[ai][bj][m][0] * wf[bj][0], acc[ai][bj][m][1] * wf[bj][1]);
                *(u32x4*)(rb + bj * 128) = pack8(acc[ai][bj][m][0] * wb[bj][0], acc[ai][bj][m][1] * wb[bj][1]); } }
}
__device__ __forceinline__ void epi_scores(EPI_ARGS, bf16_t* pbase, int ldp, int q0, int k0, float lf, float lb) {
    const int c0 = wc * 32 + 8 * fq; const int d0 = q0 - k0; const float pf = d0 > 0 ? (float)d0 : 0.f, pb = d0 < 0 ? (float)(-d0) : 0.f;
#pragma unroll
    for (int bj = 0; bj < 2; ++bj) {
        f32x4 cf[2], cb[2]; const int cc = bj * 128 + c0;
#pragma unroll
        for (int n = 0; n < 2; ++n)
#pragma unroll
            for (int j = 0; j < 4; ++j) { const float ki = (float)(cc + 4 * n + j); cf[n][j] = __builtin_amdgcn_exp2f(-lf * ki); cb[n][j] = __builtin_amdgcn_exp2f(lb * (pb + ki)); }
#pragma unroll
        for (int ai = 0; ai < 2; ++ai)
#pragma unroll
            for (int m = 0; m < 4; ++m) { const int qi = ai * 128 + wr * 64 + m * 16 + fr;
                const float rf = __builtin_amdgcn_exp2f(lf * (pf + (float)qi)), rb = __builtin_amdgcn_exp2f(-lb * (float)qi); const int dq = d0 + qi - cc;
                f32x4 o[2];
#pragma unroll
                for (int n = 0; n < 2; ++n)
#pragma unroll
                    for (int j = 0; j < 4; ++j) { const int dlt = dq - (4 * n + j); const float w = dlt > 0 ? rf * cf[n][j] : (dlt < 0 ? rb * cb[n][j] : 2.0f); o[n][j] = acc[ai][bj][m][n][j] * w; }
                *(u32x4*)(pbase + (size_t)(q0 + qi) * ldp + k0 + cc) = pack8(o[0], o[1]);
                asm volatile("" ::: "memory"); }
    }
}
__device__ __forceinline__ void epi_pv(EPI_ARGS, LAS unsigned char* xl, bf16_t* gbuf, const float* g_ret, int tok0, int h) {
    LAS f32x2* P = (LAS f32x2*)xl;
    const int e0 = wc * 32 + 8 * fq;
    bf16_t* gp = gbuf + (size_t)(tok0 + wr * 64 + fr) * D + h * 256 + e0;
    u32x4 gv0[4][2];
#pragma unroll
    for (int m = 0; m < 4; ++m)
#pragma unroll
        for (int bj = 0; bj < 2; ++bj) gv0[m][bj] = *(const u32x4*)(gp + (size_t)(m * 16) * D + bj * 128);
    f32x4 gr[2][2];
#pragma unroll
    for (int bj = 0; bj < 2; ++bj) { gr[bj][0] = *(const f32x4*)(g_ret + h * 256 + bj * 128 + e0); gr[bj][1] = *(const f32x4*)(g_ret + h * 256 + bj * 128 + e0 + 4); }
#pragma unroll
    for (int ai = 0; ai < 2; ++ai)
#pragma unroll
        for (int m = 0; m < 4; ++m) { float s = 0.f, q = 0.f;
#pragma unroll
            for (int bj = 0; bj < 2; ++bj)
#pragma unroll
                for (int n = 0; n < 2; ++n) { const f32x4 x = acc[ai][bj][m][n]; s += (x[0] + x[1]) + (x[2] + x[3]); q += (x[0] * x[0] + x[1] * x[1]) + (x[2] * x[2] + x[3] * x[3]); }
            s += __shfl_xor(s, 16); s += __shfl_xor(s, 32); q += __shfl_xor(q, 16); q += __shfl_xor(q, 32);
            if (fq == 0) P[(ai * 128 + wr * 64 + m * 16 + fr) * 4 + wc] = (f32x2){s, q}; }
    WG_BAR();
#pragma unroll
    for (int ai = 0; ai < 2; ++ai) {
        u32x4 gv[4][2];
#pragma unroll
        for (int m = 0; m < 4; ++m)
#pragma unroll
            for (int bj = 0; bj < 2; ++bj) gv[m][bj] = ai == 0 ? gv0[m][bj] : *(const u32x4*)(gp + (size_t)(ai * 128 + m * 16) * D + bj * 128);
#pragma unroll
        for (int m = 0; m < 4; ++m) { const int r = ai * 128 + wr * 64 + m * 16 + fr;
            const f32x2 pa = P[r * 4 + 0], pb = P[r * 4 + 1], pc = P[r * 4 + 2], pd = P[r * 4 + 3];
            const float mean = ((pa.x + pb.x) + (pc.x + pd.x)) * (1.f / 256.f); float var = ((pa.y + pb.y) + (pc.y + pd.y)) * (1.f / 256.f) - mean * mean; var = var > 0.f ? var : 0.f;
            const float rstd = 1.0f / sqrtf(var + EPS);
#pragma unroll
            for (int bj = 0; bj < 2; ++bj) { f32x4 s0, s1; unpack8(gv[m][bj], s0, s1);
                const f32x4 o0 = (acc[ai][bj][m][0] - mean) * rstd * gr[bj][0] * s0, o1 = (acc[ai][bj][m][1] - mean) * rstd * gr[bj][1] * s1;
                *(u32x4*)(gp + (size_t)(ai * 128 + m * 16) * D + bj * 128) = pack8(o0, o1); } }
    }
    WG_BAR();
}
__device__ __forceinline__ void epi_state(EPI_ARGS, float* out) {
    const int bh = u.aux, e0 = wc * 32 + 8 * fq;
#pragma unroll
    for (int ai = 0; ai < 2; ++ai) { float* sb = out + (size_t)M * D + (size_t)ai * (32 * 4 * 128 * 256) + (size_t)bh * (128 * 256);
#pragma unroll
        for (int m = 0; m < 4; ++m) { float* rp = sb + (size_t)(wr * 64 + m * 16 + fr) * 256 + e0;
#pragma unroll
            for (int bj = 0; bj < 2; ++bj) { *(f32x4*)(rp + bj * 128) = acc[ai][bj][m][0]; *(f32x4*)(rp + bj * 128 + 4) = acc[ai][bj][m][1]; } } }
}
__device__ __forceinline__ void epi_spatial(EPI_ARGS, bf16_t* ubuf, const float* b_sp) {
    const int cp = u.pm, g = u.pn, c0 = wc * 32 + 8 * fq;
    bf16_t* up = ubuf + (size_t)(cp * 256 + wr * 64 + fr) * D + g * 256 + c0;
#pragma unroll
    for (int ai = 0; ai < 2; ++ai) {
        u32x4 uv[4][2]; float bs[4];
#pragma unroll
        for (int m = 0; m < 4; ++m) { bs[m] = b_sp[g * 128 + ((wr * 64 + m * 16 + fr) & 127)];
#pragma unroll
            for (int bj = 0; bj < 2; ++bj) uv[m][bj] = *(const u32x4*)(up + (size_t)(ai * 128 + m * 16) * D + bj * 128); }
#pragma unroll
        for (int m = 0; m < 4; ++m)
#pragma unroll
            for (int bj = 0; bj < 2; ++bj) { f32x4 u0, u1; unpack8(uv[m][bj], u0, u1);
                *(u32x4*)(up + (size_t)(ai * 128 + m * 16) * D + bj * 128) = pack8(u0 * (acc[ai][bj][m][0] + bs[m]), u1 * (acc[ai][bj][m][1] + bs[m])); }
    }
}
__device__ __forceinline__ void epi_merge(EPI_ARGS, int kh, const bf16_t* gates, float* tmp, bf16_t* merged) {
    const int row0 = u.pm * 256 + wr * 64 + fr, col0 = u.pn * 256 + wc * 32 + 8 * fq;
#pragma unroll
    for (int ai = 0; ai < 2; ++ai)
#pragma unroll
      for (int mh = 0; mh < 2; ++mh) {
        u32x4 gv[2][2]; f32x4 tv[2][2][2];
#pragma unroll
        for (int mm = 0; mm < 2; ++mm)
#pragma unroll
            for (int bj = 0; bj < 2; ++bj) { const size_t row = (size_t)(row0 + ai * 128 + (mh * 2 + mm) * 16);
                gv[mm][bj] = *(const u32x4*)(gates + row * 2048 + kh * 1024 + col0 + bj * 128);
                if (kh) { const float* tp = tmp + row * D + col0 + bj * 128; tv[mm][bj][0] = *(const f32x4*)tp; tv[mm][bj][1] = *(const f32x4*)(tp + 4); } }
#pragma unroll
        for (int mm = 0; mm < 2; ++mm)
#pragma unroll
            for (int bj = 0; bj < 2; ++bj) { const int m = mh * 2 + mm; const size_t row = (size_t)(row0 + ai * 128 + m * 16); f32x4 g0, g1; unpack8(gv[mm][bj], g0, g1);
                if (kh == 0) { float* tp = tmp + row * D + col0 + bj * 128; *(f32x4*)tp = g0 * acc[ai][bj][m][0]; *(f32x4*)(tp + 4) = g1 * acc[ai][bj][m][1]; }
                else *(u32x4*)(merged + row * D + col0 + bj * 128) = pack8(tv[mm][bj][0] + g0 * acc[ai][bj][m][0], tv[mm][bj][1] + g1 * acc[ai][bj][m][1]); }
      }
}


__device__ __forceinline__ int mod_row(int row);
__device__ __forceinline__ void xchg_rows(LAS unsigned char* xl, const float (&rowss)[2][4], int pm, int pn, int wr, int wc, int fr, int fq, float* slots, unsigned* cnt) {
    LAS float* Pl = (LAS float*)xl; LAS float* S = (LAS float*)(xl + 4096);
    if (fq == 0) {
#pragma unroll
        for (int ai = 0; ai < 2; ++ai)
#pragma unroll
            for (int m = 0; m < 4; ++m) Pl[(ai * 128 + wr * 64 + m * 16 + fr) * 4 + wc] = rowss[ai][m]; }
    WG_BAR();
    const int tid = threadIdx.x;
    if (tid < 256) { const float t = (Pl[tid * 4 + 0] + Pl[tid * 4 + 1]) + (Pl[tid * 4 + 2] + Pl[tid * 4 + 3]);
        __hip_atomic_store(slots + ((size_t)(pm * 256 + tid)) * 4 + pn, t, __ATOMIC_RELAXED, __HIP_MEMORY_SCOPE_AGENT); }
    asm volatile("s_waitcnt vmcnt(0)" ::: "memory");
    WG_BAR();
    if (tid == 0) { unsigned* c = cnt + 16 * pm; __hip_atomic_fetch_add(c, 1u, __ATOMIC_RELAXED, __HIP_MEMORY_SCOPE_AGENT);
        unsigned sp = 0; while (__hip_atomic_load(c, __ATOMIC_RELAXED, __HIP_MEMORY_SCOPE_AGENT) < 4u) { __builtin_amdgcn_s_sleep(2); if (++sp > (1u << 22)) break; }
        __builtin_amdgcn_fence(__ATOMIC_ACQUIRE, "agent"); asm volatile("s_waitcnt vmcnt(0)" ::: "memory"); }
    WG_BAR();
    if (tid < 256) { float* sl = slots + ((size_t)(pm * 256 + tid)) * 4;
        const float t0 = __hip_atomic_load(sl + 0, __ATOMIC_RELAXED, __HIP_MEMORY_SCOPE_AGENT), t1 = __hip_atomic_load(sl + 1, __ATOMIC_RELAXED, __HIP_MEMORY_SCOPE_AGENT),
                    t2 = __hip_atomic_load(sl + 2, __ATOMIC_RELAXED, __HIP_MEMORY_SCOPE_AGENT), t3 = __hip_atomic_load(sl + 3, __ATOMIC_RELAXED, __HIP_MEMORY_SCOPE_AGENT);
        S[tid] = 1.0f / sqrtf(((t0 + t1) + (t2 + t3)) * (1.f / D) + EPS); }
    WG_BAR();
}
__device__ __forceinline__ void row_ssq(const f32x4 (&acc)[2][2][4][2], float (&rowss)[2][4]) {
#pragma unroll
    for (int ai = 0; ai < 2; ++ai)
#pragma unroll
        for (int m = 0; m < 4; ++m) { float s = 0.f;
#pragma unroll
            for (int bj = 0; bj < 2; ++bj)
#pragma unroll
                for (int n = 0; n < 2; ++n) { const f32x4 x = acc[ai][bj][m][n]; s += (x[0] * x[0] + x[1] * x[1]) + (x[2] * x[2] + x[3] * x[3]); }
            s += __shfl_xor(s, 16); s += __shfl_xor(s, 32); rowss[ai][m] = s; }
}
template <bool SRC_IN, bool HAS_H>
__device__ __forceinline__ void epi_norm(f32x4 (&acc)[2][2][4][2], const Unit& u, int wr, int wc, int fr, int fq, LAS unsigned char* xl, const Params& p,
                                         float coef, int ipost, int ig, bf16_t* hout, int ipre, int ish, int isc, int bank) {
    const LAS float* S = (const LAS float*)(xl + 4096);
    float* slots = (float*)(p.ws + WS_XS); unsigned* cnt = (unsigned*)(p.ws + WS_CNT);
    const int rowb = u.pm * 256 + wr * 64 + fr, colb = u.pn * 256 + wc * 32 + 8 * fq;
    const float* mr = (const float*)(p.ws + WS_MOD) + (size_t)mod_row(u.pm * 256) * (NMOD * D);
    const float* xsrc = SRC_IN ? (u.pm < 32 ? p.x_prompt : p.x_sample - (size_t)MP * D) : p.out;
    float rowss[2][4];
    row_ssq(acc, rowss);
    xchg_rows(xl, rowss, u.pm, u.pn, wr, wc, fr, fq, slots, cnt + bank * 1024);
    {
        f32x4 gpo[2][2], mg[2][2];
#pragma unroll
        for (int bj = 0; bj < 2; ++bj)
#pragma unroll
            for (int n = 0; n < 2; ++n) { gpo[bj][n] = *(const f32x4*)(p.g_norm + ipost * D + colb + bj * 128 + 4 * n) * coef; mg[bj][n] = *(const f32x4*)(mr + ig * D + colb + bj * 128 + 4 * n); }
#pragma unroll
        for (int ai = 0; ai < 2; ++ai)
#pragma unroll
            for (int mh = 0; mh < 2; ++mh) {
                f32x4 xv[2][2][2];
#pragma unroll
                for (int mm = 0; mm < 2; ++mm)
#pragma unroll
                    for (int bj = 0; bj < 2; ++bj) { const float* xp = xsrc + (size_t)(rowb + ai * 128 + (mh * 2 + mm) * 16) * D + colb + bj * 128; xv[mm][bj][0] = *(const f32x4*)xp; xv[mm][bj][1] = *(const f32x4*)(xp + 4); }
#pragma unroll
                for (int mm = 0; mm < 2; ++mm) { const int m = mh * 2 + mm; const float rs = S[ai * 128 + wr * 64 + m * 16 + fr];
#pragma unroll
                    for (int bj = 0; bj < 2; ++bj) { float* op = p.out + (size_t)(rowb + ai * 128 + m * 16) * D + colb + bj * 128;
#pragma unroll
                        for (int n = 0; n < 2; ++n) { acc[ai][bj][m][n] = xv[mm][bj][n] + mg[bj][n] * (acc[ai][bj][m][n] * rs * gpo[bj][n]); *(f32x4*)(op + 4 * n) = acc[ai][bj][m][n]; } } }
            }
    }
    if (HAS_H) {
        row_ssq(acc, rowss);
        xchg_rows(xl, rowss, u.pm, u.pn, wr, wc, fr, fq, slots + (size_t)M * 4, cnt + (bank + 1) * 1024);
        f32x4 gpr[2][2], msc[2][2], msh[2][2];
#pragma unroll
        for (int bj = 0; bj < 2; ++bj)
#pragma unroll
            for (int n = 0; n < 2; ++n) { gpr[bj][n] = *(const f32x4*)(p.g_norm + ipre * D + colb + bj * 128 + 4 * n); msc[bj][n] = *(const f32x4*)(mr + isc * D + colb + bj * 128 + 4 * n) + 1.0f; msh[bj][n] = *(const f32x4*)(mr + ish * D + colb + bj * 128 + 4 * n); }
#pragma unroll
        for (int ai = 0; ai < 2; ++ai)
#pragma unroll
            for (int m = 0; m < 4; ++m) { const float rs = S[ai * 128 + wr * 64 + m * 16 + fr];
#pragma unroll
                for (int bj = 0; bj < 2; ++bj) { const f32x4 o0 = acc[ai][bj][m][0] * rs * gpr[bj][0] * msc[bj][0] + msh[bj][0], o1 = acc[ai][bj][m][1] * rs * gpr[bj][1] * msc[bj][1] + msh[bj][1];
                    *(u32x4*)(hout + (size_t)(rowb + ai * 128 + m * 16) * D + colb + bj * 128) = pack8(o0, o1); } }
    }
}


__device__ __forceinline__ int trow192(int ai, int wr, int m, int fr) { return ai ? 128 + wr * 32 + m * 16 + fr : wr * 64 + m * 16 + fr; }
__device__ __forceinline__ void xchg_rows192(LAS unsigned char* xl, const float (&rowss)[2][4], int pm, int pn, int wr, int wc, int fr, int fq, float* slots, unsigned* cnt) {
    LAS float* Pl = (LAS float*)xl; LAS float* S = (LAS float*)(xl + 4096);
    if (fq == 0) {
#pragma unroll
        for (int ai = 0; ai < 2; ++ai)
#pragma unroll
            for (int m = 0; m < (ai ? 2 : 4); ++m) Pl[trow192(ai, wr, m, fr) * 4 + wc] = rowss[ai][m]; }
    WG_BAR();
    const int tid = threadIdx.x;
    if (tid < 192) { const float t = (Pl[tid * 4 + 0] + Pl[tid * 4 + 1]) + (Pl[tid * 4 + 2] + Pl[tid * 4 + 3]);
        __hip_atomic_store(slots + ((size_t)(pm * 192 + tid)) * 4 + pn, t, __ATOMIC_RELAXED, __HIP_MEMORY_SCOPE_AGENT); }
    asm volatile("s_waitcnt vmcnt(0)" ::: "memory");
    WG_BAR();
    if (tid == 0) { unsigned* c = cnt + 16 * pm; __hip_atomic_fetch_add(c, 1u, __ATOMIC_RELAXED, __HIP_MEMORY_SCOPE_AGENT);
        unsigned sp = 0; while (__hip_atomic_load(c, __ATOMIC_RELAXED, __HIP_MEMORY_SCOPE_AGENT) < 4u) { __builtin_amdgcn_s_sleep(2); if (++sp > (1u << 22)) break; }
        __builtin_amdgcn_fence(__ATOMIC_ACQUIRE, "agent"); asm volatile("s_waitcnt vmcnt(0)" ::: "memory"); }
    WG_BAR();
    if (tid < 192) { float* sl = slots + ((size_t)(pm * 192 + tid)) * 4;
        const float t0 = __hip_atomic_load(sl + 0, __ATOMIC_RELAXED, __HIP_MEMORY_SCOPE_AGENT), t1 = __hip_atomic_load(sl + 1, __ATOMIC_RELAXED, __HIP_MEMORY_SCOPE_AGENT),
                    t2 = __hip_atomic_load(sl + 2, __ATOMIC_RELAXED, __HIP_MEMORY_SCOPE_AGENT), t3 = __hip_atomic_load(sl + 3, __ATOMIC_RELAXED, __HIP_MEMORY_SCOPE_AGENT);
        S[tid] = 1.0f / sqrtf(((t0 + t1) + (t2 + t3)) * (1.f / D) + EPS); }
    WG_BAR();
}
__device__ __forceinline__ void row_ssq192(const f32x4 (&acc)[2][2][4][2], float (&rowss)[2][4]) {
#pragma unroll
    for (int ai = 0; ai < 2; ++ai)
#pragma unroll
        for (int m = 0; m < (ai ? 2 : 4); ++m) { float s = 0.f;
#pragma unroll
            for (int bj = 0; bj < 2; ++bj)
#pragma unroll
                for (int n = 0; n < 2; ++n) { const f32x4 x = acc[ai][bj][m][n]; s += (x[0] * x[0] + x[1] * x[1]) + (x[2] * x[2] + x[3] * x[3]); }
            s += __shfl_xor(s, 16); s += __shfl_xor(s, 32); rowss[ai][m] = s; }
}
__device__ __forceinline__ const float* xrow_in(const Params& p, int row);
template <bool SRC_IN, bool HAS_H>
__device__ __forceinline__ void epi_norm192(f32x4 (&acc)[2][2][4][2], const Unit& u, int wr, int wc, int fr, int fq, LAS unsigned char* xl, const Params& p,
                                            float coef, int ipost, int ig, bf16_t* hout, int ipre, int ish, int isc, int bank) {
    const LAS float* S = (const LAS float*)(xl + 4096);
    float* slots = (float*)(p.ws + WS_XS); unsigned* cnt = (unsigned*)(p.ws + WS_CNT);
    const int row0 = u.pm * 192, colb = u.pn * 256 + wc * 32 + 8 * fq;
    const float* modb = (const float*)(p.ws + WS_MOD);
    float rowss[2][4];
    row_ssq192(acc, rowss);
    {
        f32x4 gpo[2][2], xv[2][2][2], mgv[2][2][2];
#pragma unroll
        for (int bj = 0; bj < 2; ++bj)
#pragma unroll
            for (int n = 0; n < 2; ++n) gpo[bj][n] = *(const f32x4*)(p.g_norm + ipost * D + colb + bj * 128 + 4 * n) * coef;
#define EPN_LOADB(AI, MH) do { _Pragma("unroll") for (int mm = 0; mm < 2; ++mm) { const int grow = row0 + trow192(AI, wr, (MH) * 2 + mm, fr); \
            const float* xr = (SRC_IN ? xrow_in(p, grow) : p.out + (size_t)grow * D) + colb; const float* mr = modb + (size_t)mod_row(grow) * (NMOD * D) + ig * D + colb; \
            _Pragma("unroll") for (int bj = 0; bj < 2; ++bj) { xv[mm][bj][0] = *(const f32x4*)(xr + bj * 128); xv[mm][bj][1] = *(const f32x4*)(xr + bj * 128 + 4); mgv[mm][bj][0] = *(const f32x4*)(mr + bj * 128); mgv[mm][bj][1] = *(const f32x4*)(mr + bj * 128 + 4); } } } while (0)
#define EPN_APPLYB(AI, MH) do { _Pragma("unroll") for (int mm = 0; mm < 2; ++mm) { const int m = (MH) * 2 + mm, tr = trow192(AI, wr, m, fr); const float rs = S[tr]; float* op = p.out + (size_t)(row0 + tr) * D + colb; \
            _Pragma("unroll") for (int bj = 0; bj < 2; ++bj) _Pragma("unroll") for (int n = 0; n < 2; ++n) { acc[AI][bj][m][n] = xv[mm][bj][n] + mgv[mm][bj][n] * gpo[bj][n] * (acc[AI][bj][m][n] * rs); *(f32x4*)(op + bj * 128 + 4 * n) = acc[AI][bj][m][n]; } } } while (0)
        EPN_LOADB(0, 0);
        xchg_rows192(xl, rowss, u.pm, u.pn, wr, wc, fr, fq, slots, cnt + bank * 1024);
        EPN_APPLYB(0, 0); EPN_LOADB(0, 1); EPN_APPLYB(0, 1); EPN_LOADB(1, 0); EPN_APPLYB(1, 0);
#undef EPN_LOADB
#undef EPN_APPLYB
    }
    if (HAS_H) {
        row_ssq192(acc, rowss);
        f32x4 gpr[2][2];
#pragma unroll
        for (int bj = 0; bj < 2; ++bj)
#pragma unroll
            for (int n = 0; n < 2; ++n) gpr[bj][n] = *(const f32x4*)(p.g_norm + ipre * D + colb + bj * 128 + 4 * n);
        xchg_rows192(xl, rowss, u.pm, u.pn, wr, wc, fr, fq, slots + (size_t)M * 4, cnt + (bank + 1) * 1024);
#pragma unroll
        for (int ai = 0; ai < 2; ++ai)
#pragma unroll
            for (int m = 0; m < (ai ? 2 : 4); ++m) { const int tr = trow192(ai, wr, m, fr), grow = row0 + tr; const float rs = S[tr];
                const float* mr = modb + (size_t)mod_row(grow) * (NMOD * D) + colb;
#pragma unroll
                for (int bj = 0; bj < 2; ++bj) { const f32x4 sc0 = *(const f32x4*)(mr + isc * D + bj * 128), sc1 = *(const f32x4*)(mr + isc * D + bj * 128 + 4), sh0 = *(const f32x4*)(mr + ish * D + bj * 128), sh1 = *(const f32x4*)(mr + ish * D + bj * 128 + 4);
                    const f32x4 o0 = acc[ai][bj][m][0] * rs * gpr[bj][0] * (sc0 + 1.0f) + sh0, o1 = acc[ai][bj][m][1] * rs * gpr[bj][1] * (sc1 + 1.0f) + sh1;
                    *(u32x4*)(hout + (size_t)grow * D + colb + bj * 128) = pack8(o0, o1); } }
    }
}
struct SchedT192 {
    const char* A; const char* B; unsigned lda, ldb; int nt, G, c;
    __device__ __forceinline__ bool next(int i, Unit& u) const {
        const long L = (long)i * G + c; if (L >= 256) return false;
        int pm, pn; tile_map((int)L, 64, 4, pm, pn);
        u.a = A + (size_t)pm * 192 * lda; u.b = B + (size_t)pn * 256 * ldb; u.lda = lda; u.ldb = ldb; u.nt = nt; u.kind = K_F32; u.pm = pm; u.pn = pn; u.aux = 0; return true;
    }
};
template <int PH> struct Epi {
    Params p; LAS unsigned char* xl;
    __device__ __forceinline__ void operator()(f32x4 (&acc)[2][2][4][2], const Unit& u, int wr, int wc, int fr_, int fq_) const {
        unsigned char* ws = p.ws;
        int fr = fr_, fq = fq_; asm volatile("" : "+v"(fr), "+v"(fq));
        if constexpr (PH == 2) { epi_swiglu(acc, u, wr, wc, fr, fq, (bf16_t*)(ws + WS_ACT)); return; }
        if constexpr (PH == 3) { epi_norm192<true, true>(acc, u, wr, wc, fr, fq, xl, p, 0.5f, 1, 2, (bf16_t*)((unsigned char*)p.out + OUT_H2), 2, 3, 4, 0); return; }
        if constexpr (PH == 9) { epi_norm192<false, true>(acc, u, wr, wc, fr, fq, xl, p, 1.0f, 3, 5, (bf16_t*)(ws + WS_H3), 4, 6, 7, 2); return; }
        if constexpr (PH == 12) { epi_norm192<false, false>(acc, u, wr, wc, fr, fq, xl, p, 0.5f, 5, 8, nullptr, 0, 0, 0, 4); return; }
        const int kind = PH == 5 ? (u.kind < K_QK ? K_QK : (u.kind > K_KT ? K_KT : u.kind)) : PH == 6 ? ((u.kind == K_VT || u.kind == K_KT) ? u.kind : K_SC_P) : PH == 7 ? (u.kind < K_PV_P ? K_PV_P : (u.kind > K_SPATIAL ? K_SPATIAL : u.kind)) : (u.kind == K_MERGE0 ? K_MERGE0 : K_MERGE1);
        switch (kind) {
        case K_SWIGLU: epi_swiglu(acc, u, wr, wc, fr, fq, (bf16_t*)(ws + WS_ACT)); break;
        case K_QK: epi_qk(acc, u, wr, wc, fr, fq, (bf16_t*)(ws + (u.pn < 2 ? WS_Q : WS_K)), u.pn < 2 ? 0.08838834764831845f : 1.0f, (const float*)(ws + WS_ROPE)); break;
        case K_G: epi_act<0>(acc, u, wr, wc, fr, fq, (bf16_t*)(ws + WS_G), D, u.aux * 256); break;
        case K_U: epi_act<1>(acc, u, wr, wc, fr, fq, (bf16_t*)(ws + WS_U), D, u.aux * 256); break;
        case K_GATES: epi_act<2>(acc, u, wr, wc, fr, fq, (bf16_t*)(ws + WS_GATES), 2048, u.aux * 256); break;
        case K_VT: epi_vt(acc, u, wr, wc, fr, fq, (bf16_t*)(ws + WS_VTP), (bf16_t*)(ws + WS_VTS)); break;
        case K_GVT: epi_gvt(acc, u, wr, wc, fr, fq, (bf16_t*)(ws + WS_GVT)); break;
        case K_KT: epi_kt(acc, u, wr, wc, fr, fq, (bf16_t*)(ws + WS_KT), (const float*)(ws + WS_LG)); break;
        case K_SC_P: case K_SC_S: { const bool sm = u.kind == K_SC_S; const int bh = sm ? (u.aux >> 4) : u.aux, h = bh & 3, qi = sm ? ((u.aux >> 2) & 3) : 0, ki = sm ? (u.aux & 3) : 0;
            const float* lgt = (const float*)(ws + WS_LG);
            epi_scores(acc, u, wr, wc, fr, fq, sm ? (bf16_t*)(ws + WS_PS) + (size_t)bh * (1024 * 1280) : (bf16_t*)(ws + WS_PP) + (size_t)bh * 65536, sm ? 1280 : 256, qi * 256, ki * 256, lgt[h], lgt[4 + h]); } break;
        case K_PV_P: { const int bh = u.aux; epi_pv(acc, u, wr, wc, fr, fq, xl, (bf16_t*)(ws + WS_G), p.g_ret, (bh >> 2) * 256, bh & 3); } break;
        case K_PV_S: { const int bh = u.aux >> 2, qi = u.aux & 3; epi_pv(acc, u, wr, wc, fr, fq, xl, (bf16_t*)(ws + WS_G), p.g_ret, MP + (bh >> 2) * 1024 + qi * 256, bh & 3); } break;
        case K_STATE: epi_state(acc, u, wr, wc, fr, fq, p.out); break;
        case K_SPATIAL: epi_spatial(acc, u, wr, wc, fr, fq, (bf16_t*)(ws + WS_U), p.b_sp); break;
        case K_MERGE0: epi_merge(acc, u, wr, wc, fr, fq, 0, (const bf16_t*)(ws + WS_GATES), (float*)(ws + WS_TMP), (bf16_t*)(ws + WS_MERGED)); break;
        case K_MERGE1: epi_merge(acc, u, wr, wc, fr, fq, 1, (const bf16_t*)(ws + WS_GATES), (float*)(ws + WS_TMP), (bf16_t*)(ws + WS_MERGED)); break;
        default: break;
        }
    }
};

struct SchedSimple {
    const char* A; const char* B; unsigned lda, ldb; int nM, nN, nt, kind, aux, G, c;
    __device__ __forceinline__ bool next(int i, Unit& u) const {
        const long L = (long)i * G + c; if (L >= nM * nN) return false;
        int pm, pn; tile_map((int)L, nM, nN, pm, pn);
        u.a = A + (size_t)pm * 256 * lda; u.b = B + (size_t)pn * 256 * ldb; u.lda = lda; u.ldb = ldb; u.nt = nt; u.kind = kind; u.pm = pm; u.pn = pn; u.aux = aux; return true;
    }
};
struct SchedIn {
    const char* H; const char* W; int G, c;
    __device__ __forceinline__ bool next(int i, Unit& u) const {
        long L = (long)i * G + c; u.lda = 2048; u.ldb = 2048; u.nt = 16;
        if (L < 960) { int pm, ct; tile_map((int)L, 48, 20, pm, ct);
            int wrow, kind, aux;
            if (ct < 4) { wrow = ct * 256; kind = K_QK; aux = ct & 1; }
            else if (ct < 8) { wrow = 2048 + (ct - 4) * 256; kind = K_G; aux = ct - 4; }
            else if (ct < 12) { wrow = 3072 + (ct - 8) * 256; kind = K_U; aux = ct - 8; }
            else { wrow = 5120 + (ct - 12) * 256; kind = K_GATES; aux = ct - 12; }
            u.a = H + (size_t)pm * 256 * 2048; u.b = W + (size_t)wrow * 2048; u.kind = kind; u.pm = pm; u.pn = ct; u.aux = aux; return true; }
        L -= 960;
        if (L < 192) { int wt, tt; tile_map((int)L, 4, 48, wt, tt);
            u.a = W + (size_t)(4096 + wt * 256) * 2048; u.b = H + (size_t)tt * 256 * 2048; u.kind = K_GVT; u.pm = wt + 4; u.pn = tt; u.aux = 0; return true; }
        L -= 192;
        if (L < 128) { int wt, tt; tile_map((int)L, 4, 32, wt, tt);
            u.a = W + (size_t)(1024 + wt * 256) * 2048; u.b = H + (size_t)tt * 256 * 2048; u.kind = K_VT; u.pm = wt; u.pn = tt; u.aux = 0; return true; }
        return false;
    }
};
struct SchedScores {
    const char* Q; const char* Kb; const char* H; const char* W; int G, c;
    __device__ __forceinline__ bool fill(int L, Unit& u) const {
        const bool big = L < 128, isvt = L < 64;
        int hp, tk; tile_map(big && !isvt ? L - 64 : 0, 2, 32, hp, tk);
        const int wt = L & 3, tv = 32 + (L >> 2);
        const size_t wrow = isvt ? (size_t)(1024 + wt * 256) : (size_t)(512 + hp * 256);
        const int ttok = isvt ? tv : tk;
        const int Ls = L - 128; const bool smp = Ls < 256; const int idx = smp ? Ls : Ls - 256;
        const int bh = smp ? (idx >> 4) : idx, b = bh >> 2, h = bh & 3, qi = smp ? ((idx >> 2) & 3) : 0, ki = smp ? (idx & 3) : 0;
        const size_t qrow = smp ? (size_t)(MP + b * 1024 + qi * 256) : (size_t)(b * 256), krow = smp ? (size_t)(MP + b * 1024 + ki * 256) : (size_t)(b * 256);
        const char* sa = Q + (qrow * 512 + h * 128) * 2; const char* sb = Kb + (krow * 512 + h * 128) * 2;
        const char* ba = W + wrow * 2048; const char* bb = H + (size_t)ttok * 256 * 2048;
        u.a = big ? ba : sa; u.b = big ? bb : sb; u.lda = big ? 2048u : 1024u; u.ldb = u.lda; u.nt = big ? 16 : 2;
        u.kind = big ? (isvt ? K_VT : K_KT) : (smp ? K_SC_S : K_SC_P); u.pm = big ? (isvt ? wt : hp) : 0; u.pn = big ? ttok : 0; u.aux = big ? 0 : idx;
        return true;
    }
    __device__ __forceinline__ bool next(int i, Unit& u) const {
        if (G == 256) { if (c < 128) return i == 0 ? fill(c, u) : false; if (c < 192) return i < 2 ? fill(128 + (c - 128) * 2 + i, u) : false; return i < 4 ? fill(256 + (c - 192) * 4 + i, u) : false; }
        const long L = (long)i * G + c; return L < 512 ? fill((int)L, u) : false;
    }
};
struct SchedMix {
    const unsigned char* ws; int G, c;
    __device__ __forceinline__ bool fill(int L, Unit& u) const {
        if (L < 64) { const int bh = L >> 2, b = bh >> 2, h = bh & 3, qi = L & 3;
            u.a = (const char*)ws + WS_PS + ((size_t)(bh * 1024 + qi * 256) * 1280) * 2; u.lda = 2560; u.b = (const char*)ws + WS_VTS + ((size_t)(b * 1024 + h * 256) * 1280) * 2; u.ldb = 2560;
            u.nt = 20; u.kind = K_PV_S; u.pm = 0; u.pn = 0; u.aux = L; return true; }
        L -= 64;
        if (L < 128) { const int bh = L, b = bh >> 2, h = bh & 3;
            u.a = (const char*)ws + WS_PP + (size_t)bh * 131072; u.lda = 512; u.b = (const char*)ws + WS_VTP + ((size_t)(h * 256) * LD_VTP + b * 256) * 2; u.ldb = LD_VTP * 2;
            u.nt = 4; u.kind = K_PV_P; u.pm = 0; u.pn = 0; u.aux = bh; return true; }
        L -= 128;
        if (L < 128) { const int bh = L, b = bh >> 2, h = bh & 3;
            u.a = (const char*)ws + WS_KT + ((size_t)(h * 256) * LD_KT + b * 256) * 2; u.lda = LD_KT * 2; u.b = (const char*)ws + WS_VTP + ((size_t)(h * 256) * LD_VTP + b * 256) * 2; u.ldb = LD_VTP * 2;
            u.nt = 4; u.kind = K_STATE; u.pm = 0; u.pn = 0; u.aux = bh; return true; }
        L -= 128;
        if (L < 192) { const int cp = L >> 2, g = L & 3;
            u.a = (const char*)ws + WS_BD + (size_t)g * 131072; u.lda = 512; u.b = (const char*)ws + WS_GVT + ((size_t)(g * 256) * LD_GVT + cp * 256) * 2; u.ldb = LD_GVT * 2;
            u.nt = 4; u.kind = K_SPATIAL; u.pm = cp; u.pn = g; u.aux = 0; return true; }
        return false;
    }
    __device__ __forceinline__ bool next(int i, Unit& u) const {
        if (G >= 128) { if (c < 64) return i == 0 ? fill(c, u) : false; const long L = 64 + (long)i * (G - 64) + (c - 64); return L < 512 ? fill((int)L, u) : false; }
        const long L = (long)i * G + c; return L < 512 ? fill((int)L, u) : false;
    }
};
struct SchedSwiglu {
    const char* A; const char* B; int G, c;
    __device__ __forceinline__ bool next(int i, Unit& u) const {
        const bool sp = (G == 256); const bool halfu = sp && i == 4;
        const long L = halfu ? (long)(1024 + (c >> 1)) : (long)i * G + c;
        const bool valid = halfu ? (c < 64) : (L < (sp ? 1024 : 1056));
        int pm, pn; tile_map(valid ? (int)L : 0, 48, 22, pm, pn);
        const int ro = halfu ? (c & 1) * 128 : 0;
        u.a = A + ((size_t)pm * 256 + ro) * 2048; u.b = B + (size_t)pn * 256 * 2048; u.lda = 2048; u.ldb = 2048; u.nt = 16; u.kind = halfu ? K_SWIGLU_H : K_SWIGLU; u.pm = pm; u.pn = pn; u.aux = ro;
        return valid && (!sp || i < 5);
    }
};
struct SchedMerge {
    const unsigned char* ws; int G, c;
    __device__ __forceinline__ bool next(int i, Unit& u) const {
        const long L = (long)(i >> 1) * G + c; if (L >= 192) return false; const int kh = i & 1;
        int pm, pn; tile_map((int)L, 48, 4, pm, pn);
        u.a = (const char*)ws + (kh ? WS_U : WS_G) + (size_t)pm * 256 * 2048; u.b = (const char*)ws + (kh ? WS_WS : WS_WR) + (size_t)pn * 256 * 2048; u.lda = 2048; u.ldb = 2048; u.nt = 16;
        u.kind = kh ? K_MERGE1 : K_MERGE0; u.pm = pm; u.pn = pn; u.aux = 0; return true;
    }
};

__device__ __forceinline__ void transpose_item(const float* W, int K, int N, bf16_t* WT, int dstrow0, LAS float* scr, int k0, int n0, int lane) {
#pragma unroll
    for (int i = 0; i < 32; ++i) { const int kk = 2 * i + (lane >> 5); scr[kk * 33 + (lane & 31)] = W[(size_t)(k0 + kk) * N + n0 + (lane & 31)]; }
    LDS_WAIT();
    const int c = lane & 7;
#pragma unroll
    for (int j = 0; j < 4; ++j) { const int n = (lane >> 3) + 8 * j; const LAS float* s = scr + (8 * c) * 33 + n;
        u32x4 o; o.x = cvt_pk_bf16(s[0 * 33], s[1 * 33]); o.y = cvt_pk_bf16(s[2 * 33], s[3 * 33]); o.z = cvt_pk_bf16(s[4 * 33], s[5 * 33]); o.w = cvt_pk_bf16(s[6 * 33], s[7 * 33]);
        *(u32x4*)(WT + (size_t)(dstrow0 + n) * K + k0 + 8 * c) = o; }
    LDS_WAIT();
}
template <int MODE> __device__ __forceinline__ void conv_matrix(const float* W, int K, int N, bf16_t* WT, LAS float* scr, int gw, int NGW, int lane) {
    const int nblk = N / 32, nitems = (K / 64) * nblk;
    for (int it = gw; it < nitems; it += NGW) { const int kb = it / nblk, nb = it % nblk, n0 = nb * 32; int dr = n0;
        if (MODE == 1) { const int half = n0 / FF, cidx = n0 % FF; dr = (cidx >> 7) * 256 + half * 128 + (cidx & 127); }
        if (MODE == 2) { if (n0 < 1024) { const int seg = n0 >> 9, r = n0 & 511, head = r >> 7, dim = r & 127; dr = (seg * 2 + (head >> 1)) * 256 + (dim >> 6) * 128 + (head & 1) * 64 + (dim & 63); } }
        transpose_item(W, K, N, WT, dr, scr, kb * 64, n0, lane); }
}
__device__ __forceinline__ void conv_wkv(const float* W, bf16_t* WT, LAS float* scr, int gw, int NGW, int lane) {
    const int nblk = 1536 / 32, nitems = (D / 64) * nblk;
    for (int it = gw; it < nitems; it += NGW) { const int kb = it / nblk, nb = it % nblk, n0 = 512 + nb * 32; int dr = n0;
        if (n0 < 1024) { const int seg = n0 >> 9, r = n0 & 511, head = r >> 7, dim = r & 127; dr = (seg * 2 + (head >> 1)) * 256 + (dim >> 6) * 128 + (head & 1) * 64 + (dim & 63); }
        transpose_item(W, D, 7168, WT, dr - 512, scr, kb * 64, n0, lane); }
}
__device__ __forceinline__ const float* xrow_in(const Params& p, int row) { return row < MP ? p.x_prompt + (size_t)row * D : p.x_sample + (size_t)(row - MP) * D; }
__device__ __forceinline__ int mod_row(int row) { return row < MP ? 0 : 1 + ((row - MP) >> 10); }

template <bool HAS_F, bool HAS_H>
__device__ __forceinline__ void norm_pass(const Params& p, const float* xsrc_out  , const bf16_t* f, float coef, int ipost, int ig, bf16_t* hout, int ipre, int ish, int isc, int gw, int NGW, int lane) {
    const float* mod = (const float*)(p.ws + WS_MOD);
    f32x4 gpo[4], gpr[4], mg[4], msc[4], msh[4];
#pragma unroll
    for (int j = 0; j < 4; ++j) { if (HAS_F) gpo[j] = *(const f32x4*)(p.g_norm + ipost * D + 4 * lane + 256 * j); if (HAS_H) gpr[j] = *(const f32x4*)(p.g_norm + ipre * D + 4 * lane + 256 * j); }
    int cur_mr = -1;
    f32x4 v[4], nv[4]; u32x2 fv[4], nfv[4];
    int row = gw;
    if (row < M) { const float* xr = xsrc_out ? xsrc_out + (size_t)row * D : xrow_in(p, row);
#pragma unroll
        for (int j = 0; j < 4; ++j) { nv[j] = *(const f32x4*)(xr + 4 * lane + 256 * j); if (HAS_F) nfv[j] = *(const u32x2*)(f + (size_t)row * D + 4 * lane + 256 * j); } }
    for (; row < M; row += NGW) {
#pragma unroll
        for (int j = 0; j < 4; ++j) { v[j] = nv[j]; if (HAS_F) fv[j] = nfv[j]; }
        const int nrow = row + NGW;
        if (nrow < M) { const float* xr = xsrc_out ? xsrc_out + (size_t)nrow * D : xrow_in(p, nrow);
#pragma unroll
            for (int j = 0; j < 4; ++j) { nv[j] = *(const f32x4*)(xr + 4 * lane + 256 * j); if (HAS_F) nfv[j] = *(const u32x2*)(f + (size_t)nrow * D + 4 * lane + 256 * j); } }
        const int mrow = mod_row(row);
        if (mrow != cur_mr) { cur_mr = mrow; const float* mr = mod + (size_t)mrow * (NMOD * D);
#pragma unroll
            for (int j = 0; j < 4; ++j) { if (HAS_F) mg[j] = *(const f32x4*)(mr + ig * D + 4 * lane + 256 * j);
                if (HAS_H) { msc[j] = *(const f32x4*)(mr + isc * D + 4 * lane + 256 * j); msh[j] = *(const f32x4*)(mr + ish * D + 4 * lane + 256 * j); } } }
        if (HAS_F) {
            f32x4 ff[4]; float ss = 0.f;
#pragma unroll
            for (int j = 0; j < 4; ++j) { ff[j] = (f32x4){__uint_as_float(fv[j].x << 16), __uint_as_float(fv[j].x & 0xffff0000u), __uint_as_float(fv[j].y << 16), __uint_as_float(fv[j].y & 0xffff0000u)};
                ss += (ff[j][0] * ff[j][0] + ff[j][1] * ff[j][1]) + (ff[j][2] * ff[j][2] + ff[j][3] * ff[j][3]); }
            const float rs = coef / sqrtf(wave_sum(ss) * (1.f / D) + EPS);
#pragma unroll
            for (int j = 0; j < 4; ++j) { v[j] = v[j] + mg[j] * (ff[j] * rs * gpo[j]); *(f32x4*)(p.out + (size_t)row * D + 4 * lane + 256 * j) = v[j]; }
        }
        if (HAS_H) {
            float ss = 0.f;
#pragma unroll
            for (int j = 0; j < 4; ++j) ss += (v[j][0] * v[j][0] + v[j][1] * v[j][1]) + (v[j][2] * v[j][2] + v[j][3] * v[j][3]);
            const float rs = 1.0f / sqrtf(wave_sum(ss) * (1.f / D) + EPS);
#pragma unroll
            for (int j = 0; j < 4; ++j) { const f32x4 o = v[j] * rs * gpr[j] * (1.0f + msc[j]) + msh[j]; u32x2 w; w.x = cvt_pk_bf16(o[0], o[1]); w.y = cvt_pk_bf16(o[2], o[3]);
                *(u32x2*)(hout + (size_t)row * D + 4 * lane + 256 * j) = w; }
        }
    }
}

#define XB_TMO      128
#define XB_XCNT(j)  (256  + 64 * (j))
#define XB_XSUB(j)  (1280 + 64 * (j))
#define XB_XGEN(j)  (2304 + 64 * (j))
#define XB_TOP      3328
#define XB_TOPGEN   3392
#define XCD_BAR_WORDS 3456
#define XB_SPIN_CAP (1u << 22)

__device__ __forceinline__ unsigned xb_ld(unsigned* p)              { return __hip_atomic_load(p, __ATOMIC_RELAXED, __HIP_MEMORY_SCOPE_AGENT); }
__device__ __forceinline__ unsigned xb_add(unsigned* p, unsigned v) { return __hip_atomic_fetch_add(p, v, __ATOMIC_RELAXED, __HIP_MEMORY_SCOPE_AGENT); }
__device__ __forceinline__ unsigned xb_xcc_id() { return (unsigned)__builtin_amdgcn_s_getreg((3 << 11) | 20) & 0xFu; }
#define XB_SPIN(cond, bar) do { unsigned _sp = 0; while (cond) { __builtin_amdgcn_s_sleep(1); \
    if ((++_sp & 255u) == 0u) { if (xb_ld(&(bar)[XB_TMO])) break; if (_sp > XB_SPIN_CAP) { atomicAdd(&(bar)[XB_TMO], 1u); break; } } } } while (0)

struct XcdBarrier {
    unsigned* bar; unsigned x;
    volatile LAS unsigned* st;
};

__device__ __forceinline__ XcdBarrier xcd_barrier_post(unsigned* bar, volatile LAS unsigned* st) {
    XcdBarrier b; b.bar = bar; b.x = xb_xcc_id(); b.st = st;
    if (threadIdx.x == 0) (void)xb_add(&bar[XB_XCNT(b.x)], 1u);
    return b;
}
__device__ __forceinline__ void xcd_barrier_complete(unsigned* bar, unsigned x, unsigned& nloc, unsigned& nx) {
    const unsigned G = gridDim.x * gridDim.y * gridDim.z;
    unsigned sum, cnt, mine, sp = 0u;
    for (;;) {
        sum = 0u; cnt = 0u; mine = 0u;
#pragma unroll
        for (unsigned j = 0; j < 16; ++j) { const unsigned c = xb_ld(&bar[XB_XCNT(j)]); sum += c; cnt += (c > 0u) ? 1u : 0u; mine = (j == x) ? c : mine; }
        if (sum == G) break;
        __builtin_amdgcn_s_sleep(1);
        if ((++sp & 255u) == 0u) { if (xb_ld(&bar[XB_TMO])) break; if (sp > XB_SPIN_CAP) { atomicAdd(&bar[XB_TMO], 1u); break; } }
    }
    nloc = mine > 0u ? mine : 1u; nx = cnt > 0u ? cnt : 1u;
}

__device__ __forceinline__ void xcd_barrier(const XcdBarrier& b) {
    asm volatile("s_waitcnt vmcnt(0)" ::: "memory");
    __syncthreads();
    if (threadIdx.x == 0) {
        unsigned* bar = b.bar;
        __builtin_amdgcn_s_waitcnt(0);
        unsigned nloc = b.st[0], nx = b.st[1];
        if (nloc == 0u) { xcd_barrier_complete(bar, b.x, nloc, nx); b.st[0] = nloc; b.st[1] = nx; }
        const unsigned old = xb_add(&bar[XB_XSUB(b.x)], 1u);
        const unsigned gen = old / nloc;
        if (old + 1u == (gen + 1u) * nloc) {
            __builtin_amdgcn_fence(__ATOMIC_RELEASE, "agent");
            asm volatile("s_waitcnt vmcnt(0)" ::: "memory");
            const unsigned og = xb_add(&bar[XB_TOP], 1u);
            const unsigned tg = og / nx;
            if (og + 1u == (tg + 1u) * nx) xb_add(&bar[XB_TOPGEN], 1u);
            else XB_SPIN(xb_ld(&bar[XB_TOPGEN]) == tg, bar);
            __builtin_amdgcn_fence(__ATOMIC_ACQUIRE, "agent");
            xb_add(&bar[XB_XGEN(b.x)], 1u);
            asm volatile("s_waitcnt vmcnt(0)" ::: "memory");
        } else {
            XB_SPIN(xb_ld(&bar[XB_XGEN(b.x)]) == gen, bar);
            __builtin_amdgcn_fence(__ATOMIC_ACQUIRE, "agent");
            asm volatile("s_waitcnt vmcnt(0)" ::: "memory");
        }
    }
    __syncthreads();
}

__global__ void __launch_bounds__(512, 2) fwd_kernel(Params pa) {
    extern __shared__ __attribute__((aligned(16))) unsigned char lds_raw[];
    LAS unsigned char* lds = (LAS unsigned char*)lds_raw;
    cg::grid_group grid = cg::this_grid();
    const int G = gridDim.x, bid = blockIdx.x, NGW = G * 8, NGT = G * 512;
    const int lo = pa.ph_lo, hi = pa.ph_hi;
    typedef const __attribute__((address_space(4))) Params* KParamsPtr;
    const KParamsPtr kp = (KParamsPtr)__builtin_amdgcn_kernarg_segment_ptr();
#define LOADP KParamsPtr kq = kp; asm volatile("" : "+s"(kq)); Params p; __builtin_memcpy(&p, kq, sizeof(Params)); unsigned char* const ws = p.ws; \
    int tid_ = threadIdx.x; asm volatile("" : "+v"(tid_)); const int tid = tid_, lane = tid & 63, wave = __builtin_amdgcn_readfirstlane(tid >> 6), gw = bid * 8 + wave, gt = bid * 512 + tid; \
    LAS float* const scr = (LAS float*)(lds + wave * 16384); (void)lane; (void)gw; (void)gt; (void)scr
#ifndef PH_MASK
#define PH_MASK 0xffff
#endif
#define IN(k) (((PH_MASK >> (k)) & 1) && ((lo >> (k)) & 1))
#define SEAM(k) do { if (hi) xcd_barrier(bar); } while (0)
    if (pa.ph_hi > 1000) grid.sync();
    if (threadIdx.x < 8) ((LAS unsigned*)(lds + MISC_OFF))[threadIdx.x] = 0u;
    __syncthreads();
    XcdBarrier bar = xcd_barrier_post((unsigned*)(pa.ws + WS_BAR), (volatile LAS unsigned*)(lds + MISC_OFF));
    LAS unsigned char* const xl = lds + XL_OFF;

#ifdef NANFILL
    {
        u32x4* wsv = (u32x4*)pa.ws; const u32x4 ff = (u32x4){0xffffffffu, 0xffffffffu, 0xffffffffu, 0xffffffffu};
        const size_t lo_skip = WS_BAR / 16, hi_skip = (WS_BAR + 16384) / 16;
        for (size_t e = gt; e < WS_END / 16; e += NGT) if (e < lo_skip || e >= hi_skip) wsv[e] = ff;
        xcd_barrier(bar);
    }
#endif
    if (IN(0)) { LOADP;
        if (bid < 144) {
            LAS float* sc = (LAS float*)lds; LAS float* red = (LAS float*)(lds + 20480);
            for (int e = tid; e < 5 * D; e += 512) { const int r = e >> 10, k = e & 1023; const float x = r == 0 ? p.c_ctx[k] : p.c[(r - 1) * D + k]; sc[e] = x / (1.0f + expf(-x)); }
            __syncthreads();
            for (int it = bid; it < 144; it += G) {
                float a0 = 0.f, a1 = 0.f, a2 = 0.f, a3 = 0.f, a4 = 0.f; const float* wp = p.w_ada + (size_t)(wave * 128) * (NMOD * D) + it * 64 + lane;
#pragma unroll 16
                for (int k = 0; k < 128; ++k) { const float w = wp[(size_t)k * (NMOD * D)]; const int kk = wave * 128 + k;
                    a0 += sc[kk] * w; a1 += sc[1024 + kk] * w; a2 += sc[2048 + kk] * w; a3 += sc[3072 + kk] * w; a4 += sc[4096 + kk] * w; }
                red[(wave * 5 + 0) * 64 + lane] = a0; red[(wave * 5 + 1) * 64 + lane] = a1; red[(wave * 5 + 2) * 64 + lane] = a2; red[(wave * 5 + 3) * 64 + lane] = a3; red[(wave * 5 + 4) * 64 + lane] = a4;
                __syncthreads();
                if (tid < 320) { const int r = tid >> 6, l = tid & 63; float s = p.b_ada[it * 64 + l];
#pragma unroll
                    for (int w = 0; w < 8; ++w) s += red[(w * 5 + r) * 64 + l];
                    ((float*)(ws + WS_MOD))[(size_t)r * (NMOD * D) + it * 64 + l] = s; }
                __syncthreads();
            }
        }
        __syncthreads();
        {
            const bool spare = G > 176; const int cgw = spare ? (bid - 144) * 8 + wave : gw, cng = spare ? (G - 144) * 8 : NGW;
            if (!spare || bid >= 144) {
                conv_matrix<1>(p.w_ffn1_in, D, 2 * FF, (bf16_t*)(ws + WS_W1), scr, cgw, cng, lane);
                conv_matrix<0>(p.w_ffn1_out, FF, D, (bf16_t*)(ws + WS_W2), scr, cgw, cng, lane); } }
        if (gt < 8) ((float*)(ws + WS_LG))[gt] = lg2_decay_slow(p.decay, gt);
        for (int e = gt; e < 1024 * 64; e += NGT) {
            const int pos = e >> 6, pp = e & 63; const float freq = exp2f(-(float)(pp & 31) * (13.287712379549449f / 32.0f));
            const float ang = (float)(pp < 32 ? (pos >> 6) : (pos & 63)) * freq; float rev = ang * 0.15915494309189535f; rev -= floorf(rev);
            ((f32x2*)(ws + WS_ROPE))[e] = (f32x2){__builtin_amdgcn_cosf(rev), __builtin_amdgcn_sinf(rev)};
        }
        for (int e = gt; e < 4 * 256 * 256 / 2; e += NGT) {
            const int g = e >> 15, r = (e >> 7) & 255, c2 = (e & 127) * 2; float v0 = 0.f, v1 = 0.f;
            if ((r >> 7) == (c2 >> 7)) { const float* wp = p.w_sp + ((size_t)g * 128 + (r & 127)) * 128 + (c2 & 127); v0 = wp[0]; v1 = wp[1]; }
            ((unsigned*)(ws + WS_BD))[e] = cvt_pk_bf16(v0, v1);
        }
    }
    SEAM(0);
    if (IN(1)) { LOADP;
        norm_pass<false, true>(p, nullptr, nullptr, 0.f, 0, 0, (bf16_t*)(ws + WS_H), 0, 0, 1, gw, NGW, lane); }
    SEAM(1);
    if (IN(2)) { LOADP;  SchedSwiglu S{(const char*)(ws + WS_H), (const char*)(ws + WS_W1), G, bid}; Epi<2> E{p, xl}; gemm_phase<Epi<2>, SchedSwiglu, false, true>(lds, S, E);
        {
            const bool spare = (G == 256); const int cgw = spare ? (bid - 64) * 8 + wave : gw, cng = spare ? (G - 64) * 8 : NGW;
            if (!spare || bid >= 64) { __syncthreads();
                conv_matrix<2>(p.w_in, D, 7168, (bf16_t*)(ws + WS_WIN), scr, cgw, cng, lane);
                conv_wkv(p.w_in, (bf16_t*)((unsigned char*)p.out + OUT_WKV), scr, cgw, cng, lane);
                conv_matrix<0>(p.w_ret_br, D, D, (bf16_t*)(ws + WS_WR), scr, cgw, cng, lane);
                conv_matrix<0>(p.w_sg_br, D, D, (bf16_t*)(ws + WS_WS), scr, cgw, cng, lane);
                conv_matrix<0>(p.w_out, D, D, (bf16_t*)(ws + WS_WO), scr, cgw, cng, lane); } } }
    SEAM(2);
    if (IN(3)) { LOADP;  SchedT192 S{(const char*)(ws + WS_ACT), (const char*)(ws + WS_W2), FF * 2, FF * 2, 44, G, bid}; Epi<3> E{p, xl}; gemm_phase<Epi<3>, SchedT192, true>(lds, S, E); }
    SEAM(3);
    if (IN(5)) { LOADP;  SchedIn S{(const char*)p.out + OUT_H2, (const char*)(ws + WS_WIN), G, bid}; Epi<5> E{p, xl}; gemm_phase(lds, S, E); }
    SEAM(5);
    if (IN(6)) { LOADP;
        { SchedScores S{(const char*)(ws + WS_Q), (const char*)(ws + WS_K), (const char*)p.out + OUT_H2, (const char*)p.out + OUT_WKV - (size_t)512 * 2048, G, bid}; Epi<6> E{p, xl}; gemm_phase(lds, S, E); }
        __syncthreads();
#ifndef NO_P6_PASSES
        {
            bf16_t* gvt = (bf16_t*)(ws + WS_GVT); LAS float* red = (LAS float*)lds;
            const int rsub = tid >> 3, c8 = tid & 7;
            for (int it = (G == 256 ? (bid < 192 ? bid : M / 64) : bid); it < M / 64; it += G) {
                const int t0 = it * 64 + 8 * c8; float s[8], q[8];
#pragma unroll
                for (int j = 0; j < 8; ++j) { s[j] = 0.f; q[j] = 0.f; }
#pragma unroll 4
                for (int sw = 0; sw < 16; ++sw) { const int ch = sw * 64 + rsub; f32x4 a, b; unpack8(*(const u32x4*)(gvt + (size_t)ch * LD_GVT + t0), a, b);
#pragma unroll
                    for (int j = 0; j < 4; ++j) { s[j] += a[j]; q[j] += a[j] * a[j]; s[4 + j] += b[j]; q[4 + j] += b[j] * b[j]; } }
#pragma unroll
                for (int j = 0; j < 8; ++j) { s[j] += __shfl_xor(s[j], 8); s[j] += __shfl_xor(s[j], 16); s[j] += __shfl_xor(s[j], 32); q[j] += __shfl_xor(q[j], 8); q[j] += __shfl_xor(q[j], 16); q[j] += __shfl_xor(q[j], 32); }
                if (lane < 8) {
#pragma unroll
                    for (int j = 0; j < 8; ++j) { red[(wave * 64 + 8 * c8 + j) * 2 + 0] = s[j]; red[(wave * 64 + 8 * c8 + j) * 2 + 1] = q[j]; } }
                __syncthreads();
                float mean[8], rstd[8];
#pragma unroll
                for (int j = 0; j < 8; ++j) { float ss = 0.f, qq = 0.f;
#pragma unroll
                    for (int w = 0; w < 8; ++w) { ss += red[(w * 64 + 8 * c8 + j) * 2 + 0]; qq += red[(w * 64 + 8 * c8 + j) * 2 + 1]; }
                    mean[j] = ss * (1.f / D); float var = qq * (1.f / D) - mean[j] * mean[j]; var = var > 0.f ? var : 0.f; rstd[j] = 1.0f / sqrtf(var + EPS); }
#pragma unroll 4
                for (int sw = 0; sw < 16; ++sw) { const int ch = sw * 64 + rsub; bf16_t* ptr = gvt + (size_t)ch * LD_GVT + t0; f32x4 a, b; unpack8(*(const u32x4*)ptr, a, b);
                    const float gs = p.g_sg[ch], bs = p.b_sg[ch];
#pragma unroll
                    for (int j = 0; j < 4; ++j) { a[j] = (a[j] - mean[j]) * rstd[j] * gs + bs; b[j] = (b[j] - mean[4 + j]) * rstd[4 + j] * gs + bs; }
                    *(u32x4*)ptr = pack8(a, b); }
                __syncthreads();
            }
        }
        {
            const bf16_t* qb = (const bf16_t*)(ws + WS_Q); bf16_t* ps = (bf16_t*)(ws + WS_PS); const float* lgt = (const float*)(ws + WS_LG);
            for (int e = gt; e < MS * 4 * 16; e += NGT) { const int dc = e & 15, h = (e >> 4) & 3, tok = e >> 6, b = tok >> 10, pos = tok & 1023;
                f32x4 q0, q1; unpack8(*(const u32x4*)(qb + (size_t)(MP + tok) * 512 + h * 128 + dc * 8), q0, q1);
                const float ff = exp2f(lgt[h] * (float)(pos + 1)), fb = exp2f(lgt[4 + h] * (float)(1024 - pos));
                bf16_t* dst = ps + ((size_t)((b * 4 + h) * 1024 + pos)) * 1280 + 1024 + dc * 8;
                *(u32x4*)dst = pack8(q0 * ff, q1 * ff); *(u32x4*)(dst + 128) = pack8(q0 * fb, q1 * fb); }
        }
        {
            bf16_t* vts = (bf16_t*)(ws + WS_VTS);
            for (int e = gt; e < 32 * 256 * 16; e += NGT) { const int ee = e & 255, dc = (e >> 8) & 15, bhd = e >> 12, dir = bhd & 1, bh = bhd >> 1;
                const float* src = (dir ? p.s0b : p.s0f) + ((size_t)bh * 128 + dc * 8) * 256 + ee;
                u32x4 o; o.x = cvt_pk_bf16(src[0], src[256]); o.y = cvt_pk_bf16(src[512], src[768]); o.z = cvt_pk_bf16(src[1024], src[1280]); o.w = cvt_pk_bf16(src[1536], src[1792]);
                *(u32x4*)(vts + ((size_t)((bh >> 2) * 1024 + (bh & 3) * 256 + ee)) * 1280 + 1024 + dir * 128 + dc * 8) = o; }
        }
#endif
    }
    SEAM(6);
    if (IN(7)) { LOADP;  SchedMix S{ws, G, bid}; Epi<7> E{p, xl}; gemm_phase(lds, S, E); }
    SEAM(7);
    if (IN(8)) { LOADP;
        {   const bool spare = G > 192; const int cgw = spare ? (bid - 192) * 8 + wave : gw, cng = spare ? (G - 192) * 8 : NGW;
            if (!spare || bid >= 192) {
                conv_matrix<1>(p.w_ffn2_in, D, 2 * FF, (bf16_t*)(ws + WS_W3), scr, cgw, cng, lane);
                conv_matrix<0>(p.w_ffn2_out, FF, D, (bf16_t*)(ws + WS_W4), scr, cgw, cng, lane);
                __syncthreads(); } }
        SchedMerge S{ws, G, bid}; Epi<8> E{p, xl}; gemm_phase(lds, S, E);
    }
    SEAM(8);
    if (IN(9)) { LOADP;  SchedT192 S{(const char*)(ws + WS_MERGED), (const char*)(ws + WS_WO), 2048, 2048, 16, G, bid}; Epi<9> E{p, xl}; gemm_phase<Epi<9>, SchedT192, true>(lds, S, E); }
    SEAM(9);
    if (IN(11)) { LOADP;  SchedSwiglu S{(const char*)(ws + WS_H3), (const char*)(ws + WS_W3), G, bid}; Epi<2> E{p, xl}; gemm_phase<Epi<2>, SchedSwiglu, false, true>(lds, S, E); }
    SEAM(11);
    if (IN(12)) { LOADP;  SchedT192 S{(const char*)(ws + WS_ACT), (const char*)(ws + WS_W4), FF * 2, FF * 2, 44, G, bid}; Epi<12> E{p, xl}; gemm_phase<Epi<12>, SchedT192, true>(lds, S, E); }
#undef IN
#undef SEAM
}

#ifndef RUN_MASK
#define RUN_MASK 0x3fff
#endif
#ifndef MK_N_LAUNCHES
#define MK_N_LAUNCHES 1
#endif
extern "C" void kernel_launch(void* const* d_in, const int* in_sizes, int n_in, void* d_out, int out_size, void* d_ws, size_t ws_size, hipStream_t stream) {
    static int grid = 0;
    if (grid == 0) {
        if (n_in != 23 || ws_size < WS_END) { fprintf(stderr, "kernel_launch: unexpected inputs (n_in %d, ws %zu)\n", n_in, ws_size); grid = -1; return; }
        int dev = 0, cus = 0, per_cu = 0;
        if (hipGetDevice(&dev) != hipSuccess || hipDeviceGetAttribute(&cus, hipDeviceAttributeMultiprocessorCount, dev) != hipSuccess) { grid = -1; return; }
        if (hipFuncSetAttribute((const void*)fwd_kernel, hipFuncAttributeMaxDynamicSharedMemorySize, LDS_BYTES) != hipSuccess) { fprintf(stderr, "kernel_launch: hipFuncSetAttribute failed\n"); grid = -1; return; }
        if (hipOccupancyMaxActiveBlocksPerMultiprocessor(&per_cu, (const void*)fwd_kernel, 512, LDS_BYTES) != hipSuccess || per_cu < 1) { fprintf(stderr, "kernel_launch: occupancy query says %d\n", per_cu); per_cu = 1; }
        (void)hipGetLastError();
        grid = cus;
    }
    if (grid < 0) return;
    Params p{};
    p.x_prompt = (const float*)d_in[0]; p.x_sample = (const float*)d_in[1]; p.s0f = (const float*)d_in[2]; p.s0b = (const float*)d_in[3]; p.c = (const float*)d_in[4]; p.c_ctx = (const float*)d_in[5];
    p.w_ada = (const float*)d_in[6]; p.b_ada = (const float*)d_in[7]; p.g_norm = (const float*)d_in[8]; p.w_ffn1_in = (const float*)d_in[9]; p.w_ffn1_out = (const float*)d_in[10]; p.w_in = (const float*)d_in[11];
    p.decay = (const float*)d_in[12]; p.g_ret = (const float*)d_in[13]; p.w_ret_br = (const float*)d_in[14]; p.g_sg = (const float*)d_in[15]; p.b_sg = (const float*)d_in[16]; p.w_sp = (const float*)d_in[17]; p.b_sp = (const float*)d_in[18];
    p.w_sg_br = (const float*)d_in[19]; p.w_out = (const float*)d_in[20]; p.w_ffn2_in = (const float*)d_in[21]; p.w_ffn2_out = (const float*)d_in[22];
    p.out = (float*)d_out; p.ws = (unsigned char*)d_ws;
#if MK_N_LAUNCHES == 1
    (void)hipMemsetAsync((char*)d_ws + WS_BAR, 0, 65536, stream);
    p.ph_lo = RUN_MASK; p.ph_hi = 1;
    void* args[] = {&p};
    hipError_t e = hipLaunchCooperativeKernel((const void*)fwd_kernel, dim3(grid), dim3(512), args, LDS_BYTES, stream);
    if (e != hipSuccess) fprintf(stderr, "kernel_launch: cooperative launch failed: %s (grid %d)\n", hipGetErrorString(e), grid);
#else
    for (int ph = 0; ph < 14; ++ph) { p.ph_lo = 1 << ph; p.ph_hi = 0; hipLaunchKernelGGL(fwd_kernel, dim3(grid), dim3(512), LDS_BYTES, stream, p); }
#endif
}
```

```cpp
#include <hip/hip_runtime.h>
#include <hip/hip_cooperative_groups.h>
#include <cstdio>
#include <cstdint>
namespace cg = cooperative_groups;

#define LAS __attribute__((address_space(3)))
typedef unsigned short bf16_t;
typedef short bf16x8 __attribute__((ext_vector_type(8)));
typedef float f32x4 __attribute__((ext_vector_type(4)));
typedef float f32x2 __attribute__((ext_vector_type(2)));
typedef unsigned u32x4 __attribute__((ext_vector_type(4)));
typedef unsigned u32x2 __attribute__((ext_vector_type(2)));

constexpr int D = 1024, MP = 8192, MS = 4096, M = 12288, FF = 2816, NMOD = 9;
constexpr float EPS = 1e-6f;
constexpr size_t MiB = 1u << 20, KiB = 1u << 10;
constexpr size_t WS_WR = 0, WS_WS = 2 * MiB, WS_WO = 4 * MiB, WS_BD = 6 * MiB, WS_MOD = 6 * MiB + 512 * KiB, WS_ROPE = 7 * MiB, WS_LG = 6 * MiB + 768 * KiB, WS_BAR = 6 * MiB + 832 * KiB, WS_CNT = WS_BAR + 16 * KiB, WS_XS = 7 * MiB + 512 * KiB;
constexpr size_t WS_W1 = 8 * MiB, WS_W2 = 19 * MiB, WS_WIN = 24 * MiB + 512 * KiB, WS_H = 38 * MiB + 512 * KiB;
constexpr size_t WS_PP = 8 * MiB, WS_PS = 24 * MiB;
constexpr size_t WS_W3 = 8 * MiB, WS_W4 = 19 * MiB, WS_H3 = 24 * MiB + 512 * KiB;
constexpr int LD_VTP = MP + 64, LD_KT = MP + 64, LD_GVT = M + 64;
constexpr size_t WS_Q = 64 * MiB, WS_K = 76 * MiB, WS_VTP = 88 * MiB, WS_VTS = 105 * MiB, WS_KT = 115 * MiB, WS_G = 132 * MiB, WS_U = 156 * MiB,
                 WS_GVT = 180 * MiB, WS_GATES = 205 * MiB;
constexpr size_t WS_ACT = 64 * MiB, WS_F = 130 * MiB, WS_TMP = 64 * MiB, WS_MERGED = 180 * MiB, WS_Y = 132 * MiB, WS_END = 253 * MiB;
static_assert((size_t)1024 * LD_VTP * 2 <= 17 * MiB && (size_t)1024 * LD_GVT * 2 <= 25 * MiB, "padded buffers fit");
constexpr size_t OUT_H2 = (size_t)M * D * 4, OUT_WKV = OUT_H2 + 24 * MiB;
constexpr int LDS_BYTES = 147456, XL_OFF = 131072, MISC_OFF = 131072 + 8192;

struct Params {
    const float* x_prompt; const float* x_sample; const float* s0f; const float* s0b; const float* c; const float* c_ctx;
    const float* w_ada; const float* b_ada; const float* g_norm; const float* w_ffn1_in; const float* w_ffn1_out; const float* w_in;
    const float* decay; const float* g_ret; const float* w_ret_br; const float* g_sg; const float* b_sg; const float* w_sp; const float* b_sp;
    const float* w_sg_br; const float* w_out; const float* w_ffn2_in; const float* w_ffn2_out;
    float* out; unsigned char* ws; int ph_lo, ph_hi;
};

typedef __bf16 bf16x2_t __attribute__((ext_vector_type(2)));
__device__ __forceinline__ unsigned cvt_pk_bf16(float lo, float hi) { const f32x2 v = {lo, hi}; const bf16x2_t b = __builtin_convertvector(v, bf16x2_t); return __builtin_bit_cast(unsigned, b); }
__device__ __forceinline__ u32x4 pack8(f32x4 a, f32x4 b) { u32x4 w; w.x = cvt_pk_bf16(a[0], a[1]); w.y = cvt_pk_bf16(a[2], a[3]); w.z = cvt_pk_bf16(b[0], b[1]); w.w = cvt_pk_bf16(b[2], b[3]); return w; }
__device__ __forceinline__ void unpack8(u32x4 w, f32x4& a, f32x4& b) {
    a[0] = __uint_as_float(w.x << 16); a[1] = __uint_as_float(w.x & 0xffff0000u); a[2] = __uint_as_float(w.y << 16); a[3] = __uint_as_float(w.y & 0xffff0000u);
    b[0] = __uint_as_float(w.z << 16); b[1] = __uint_as_float(w.z & 0xffff0000u); b[2] = __uint_as_float(w.w << 16); b[3] = __uint_as_float(w.w & 0xffff0000u);
}
__device__ __forceinline__ float fsigmoid(float x) { return __builtin_amdgcn_rcpf(1.f + __builtin_amdgcn_exp2f(-1.44269504f * x)); }
__device__ __forceinline__ float fsilu(float x) { return x * fsigmoid(x); }
__device__ __forceinline__ float fgelu(float x) { const float z = 0.7978845608f * (x + 0.044715f * x * x * x); return x * fsigmoid(2.f * z); }
__device__ __forceinline__ f32x4 silu4(f32x4 v) { return (f32x4){fsilu(v[0]), fsilu(v[1]), fsilu(v[2]), fsilu(v[3])}; }
__device__ __forceinline__ f32x4 gelu4(f32x4 v) { return (f32x4){fgelu(v[0]), fgelu(v[1]), fgelu(v[2]), fgelu(v[3])}; }
__device__ __forceinline__ f32x4 sigm4(f32x4 v) { return (f32x4){fsigmoid(v[0]), fsigmoid(v[1]), fsigmoid(v[2]), fsigmoid(v[3])}; }
__device__ __forceinline__ float wave_sum(float v) {
#pragma unroll
    for (int o = 1; o < 64; o <<= 1) v += __shfl_xor(v, o);
    return v;
}
__device__ __forceinline__ float lg2_decay_slow(const float* decay, int i) { const float x = decay[i]; return -log1pf(expf(-x)) * 1.44269504f; }
__device__ __forceinline__ float lg2_decay(const float* lgt, int dir, int h) { return lgt[dir * 4 + h]; }
#define LDS_WAIT() asm volatile("s_waitcnt lgkmcnt(0)" ::: "memory")
#define WG_BAR() do { asm volatile("s_waitcnt lgkmcnt(0)" ::: "memory"); __builtin_amdgcn_s_barrier(); asm volatile("" ::: "memory"); } while (0)

constexpr int HTB = 128 * 64 * 2;
__device__ __forceinline__ int lds_byte(int r, int c) { const int st = (r >> 4) * 2 + (c >> 5), rr = r & 15, cc = c & 31, ob = rr * 64 + cc * 2; return st * 1024 + (ob ^ (((ob >> 9) & 1) << 5)); }
__device__ __forceinline__ void stage_rc(int b, int& R, int& C) { const int st = b / 1024, sb = b % 1024, swz = sb ^ (((sb >> 9) & 1) << 5); R = (st >> 1) * 16 + swz / 64; C = (st & 1) * 32 + (swz % 64) / 2; }
__device__ __forceinline__ int perm32(int rho) { const int n = rho >> 4, i = rho & 15; return 8 * (i >> 2) + 4 * n + (i & 3); }

struct Unit { const char* a; const char* b; unsigned lda, ldb; int nt, kind, pm, pn, aux; };

__device__ __forceinline__ void tile_map(int idx, int nM, int nN, int& pm, int& pn) {
    const int nwg = nM * nN; int wgid = idx;
    { const int q = nwg / 8, r = nwg % 8, xcd = wgid % 8, off = wgid / 8; wgid = (xcd < r ? xcd * (q + 1) : r * (q + 1) + (xcd - r) * q) + off; }
    const int nig = 8 * nN, gid = wgid / nig, fm = gid * 8, gsz = (nM - fm) < 8 ? (nM - fm) : 8;
    pm = fm + ((wgid % nig) % gsz); pn = (wgid % nig) / gsz;
}

#define EPI_ARGS const f32x4 (&acc)[2][2][4][2], const Unit& u, int wr, int wc, int fr, int fq

constexpr int UNIT_HALF_KIND = 17;
template <class Epi, class Sched, bool HM2 = false, bool HC = false>
__device__ __forceinline__ void gemm_phase(LAS unsigned char* lds, const Sched& S, const Epi& E) {
    const int tid = threadIdx.x, wid = __builtin_amdgcn_readfirstlane(tid >> 6), lane = tid & 63, wr = wid >> 2, wc = wid & 3, fr = lane & 15, fq = lane >> 4;
    int RA, RB, C2;
    { int R, C; stage_rc(tid * 16, R, C); RA = R; RB = (R & ~31) + perm32(R & 31); C2 = C * 2; }
    const unsigned ldsw = (unsigned)wid * 1024u;
    const int aoff = lds_byte(wr * 64 + fr, fq * 8), boff = lds_byte(wc * 32 + fr, fq * 8);
#define PG8_SA(b, h) (((b) * 2 + (h)) * HTB)
#define PG8_SB(b, h) ((4 + (b) * 2 + (h)) * HTB)
#define PG8_STAGE(bufoff, gbase, RR, ld) do { const unsigned _vo = (unsigned)(RR * (int)(ld) + C2); _Pragma("unroll") for (int _i = 0; _i < 2; ++_i) { \
        const char* _gb = (const char*)(gbase) + (size_t)(_i * 64u * (ld)); asm volatile("" : "+s"(_gb)); \
        __builtin_amdgcn_global_load_lds((const unsigned*)(_gb + _vo), (LAS unsigned*)(lds + (bufoff) + ldsw + _i * 8192), 16, 0, 0); } } while (0)
#define PG8_STAGE_A1(bufoff, gbase, ld) do { if (HM2) { const unsigned _vo = (unsigned)((RA & 31) * (int)(ld) + C2); _Pragma("unroll") for (int _i = 0; _i < 2; ++_i) { \
        const char* _gb = (const char*)(gbase) + (size_t)(_i * 32u * (ld)); asm volatile("" : "+s"(_gb)); \
        __builtin_amdgcn_global_load_lds((const unsigned*)(_gb + _vo), (LAS unsigned*)(lds + (bufoff) + ldsw + _i * 8192), 16, 0, 0); } } else PG8_STAGE(bufoff, gbase, RA, ld); } while (0)
#define PG8_LDA1(dst, b) do { _Pragma("unroll") for (int m = 0; m < (HM2 ? 2 : 4); ++m) _Pragma("unroll") for (int k = 0; k < 2; ++k) dst[m][k] = *(const LAS bf16x8*)(lds + PG8_SA(b, 1) + aoff + m * 2048 + k * 1024); } while (0)
#define PG8_MMA1(bj, At, Bt) do { __builtin_amdgcn_s_setprio(1); _Pragma("unroll") for (int m = 0; m < (HM2 ? 2 : 4); ++m) _Pragma("unroll") for (int n = 0; n < 2; ++n) _Pragma("unroll") for (int k = 0; k < 2; ++k) \
        acc[1][bj][m][n] = __builtin_amdgcn_mfma_f32_16x16x32_bf16(Bt[n][k], At[m][k], acc[1][bj][m][n], 0, 0, 0); __builtin_amdgcn_s_setprio(0); } while (0)
#define PG8_LDA(dst, b, h) do { _Pragma("unroll") for (int m = 0; m < 4; ++m) _Pragma("unroll") for (int k = 0; k < 2; ++k) dst[m][k] = *(const LAS bf16x8*)(lds + PG8_SA(b, h) + aoff + m * 2048 + k * 1024); } while (0)
#define PG8_LDB(dst, b, h) do { _Pragma("unroll") for (int n = 0; n < 2; ++n) _Pragma("unroll") for (int k = 0; k < 2; ++k) dst[n][k] = *(const LAS bf16x8*)(lds + PG8_SB(b, h) + boff + n * 2048 + k * 1024); } while (0)
#define PG8_MMA(ai, bj, At, Bt) do { __builtin_amdgcn_s_setprio(1); _Pragma("unroll") for (int m = 0; m < 4; ++m) _Pragma("unroll") for (int n = 0; n < 2; ++n) _Pragma("unroll") for (int k = 0; k < 2; ++k) \
        acc[ai][bj][m][n] = __builtin_amdgcn_mfma_f32_16x16x32_bf16(Bt[n][k], At[m][k], acc[ai][bj][m][n], 0, 0, 0); __builtin_amdgcn_s_setprio(0); } while (0)
#define PG8_WAIT_V(n) asm volatile("s_waitcnt vmcnt(" #n ")" ::: "memory")
#define PG8_WAIT_L(n) asm volatile("s_waitcnt lgkmcnt(" #n ")" ::: "memory")
#define PG8_BAR __builtin_amdgcn_s_barrier()
#define PG8_SCHED __builtin_amdgcn_sched_barrier(0)
    Unit cur, nxt; int ui = 0;
    if (!S.next(0, cur)) return;
    f32x4 acc[2][2][4][2];
#pragma unroll
    for (int a = 0; a < 2; ++a)
#pragma unroll
        for (int b = 0; b < 2; ++b)
#pragma unroll
            for (int m = 0; m < 4; ++m)
#pragma unroll
                for (int n = 0; n < 2; ++n) acc[a][b][m][n] = (f32x4){0.f, 0.f, 0.f, 0.f};
    bf16x8 At[4][2], B0[2][2], B1[2][2];
    const char* cA = cur.a; const char* cB = cur.b; unsigned cla = cur.lda, clb = cur.ldb;
    PG8_STAGE(PG8_SB(0, 0), cB, RB, clb); PG8_STAGE(PG8_SB(0, 1), cB + 128u * clb, RB, clb); PG8_STAGE(PG8_SA(0, 0), cA, RA, cla); PG8_STAGE_A1(PG8_SA(0, 1), cA + 128u * cla, cla);
    if (wr == 1) PG8_BAR;
    PG8_WAIT_V(2); PG8_BAR;
    PG8_STAGE(PG8_SB(1, 0), cB + 128, RB, clb); PG8_STAGE(PG8_SA(1, 0), cA + 128, RA, cla); PG8_STAGE(PG8_SB(1, 1), cB + 128u * clb + 128, RB, clb);
    PG8_WAIT_V(6); PG8_BAR;
    for (;;) {
        const bool has_next = S.next(ui + 1, nxt);
        const char* nA = has_next ? nxt.a : cA; const char* nB = has_next ? nxt.b : cB;
        const unsigned nla = has_next ? nxt.lda : cla, nlb = has_next ? nxt.ldb : clb;
        const int nt = cur.nt; const bool halfu = HC && cur.kind == UNIT_HALF_KIND;
        for (int t = 0; t < nt; t += 2) {
            const bool last = (t == nt - 2);
            const char* a1 = cA + (size_t)(t + 1) * 128;
            const char* a2 = last ? nA : cA + (size_t)(t + 2) * 128; const char* b2 = last ? nB : cB + (size_t)(t + 2) * 128;
            const unsigned la2 = last ? nla : cla, lb2 = last ? nlb : clb;
            const char* a3 = a2 + 128; const char* b3 = b2 + 128;
            PG8_LDB(B0, 0, 0); PG8_LDB(B1, 0, 1); PG8_SCHED; PG8_LDA(At, 0, 0); PG8_STAGE_A1(PG8_SA(1, 1), a1 + 128u * cla, cla);
            PG8_WAIT_V(8); PG8_WAIT_L(0); PG8_BAR; PG8_MMA(0, 0, At, B0); PG8_MMA(0, 1, At, B1); PG8_BAR; PG8_SCHED;
            if (!halfu) PG8_LDA1(At, 0); PG8_STAGE(PG8_SB(0, 0), b2, RB, lb2); PG8_STAGE(PG8_SB(0, 1), b2 + 128u * lb2, RB, lb2); PG8_STAGE(PG8_SA(0, 0), a2, RA, la2);
            PG8_WAIT_V(8); PG8_WAIT_L(0); PG8_BAR; if (!halfu) { PG8_MMA1(0, At, B0); PG8_MMA1(1, At, B1); } PG8_BAR; PG8_SCHED;
            PG8_LDB(B0, 1, 0); PG8_LDB(B1, 1, 1); PG8_SCHED; PG8_LDA(At, 1, 0); PG8_STAGE_A1(PG8_SA(0, 1), a2 + 128u * la2, la2);
            PG8_WAIT_V(8); PG8_WAIT_L(0); PG8_BAR; PG8_MMA(0, 0, At, B0); PG8_MMA(0, 1, At, B1); PG8_BAR; PG8_SCHED;
            if (!halfu) PG8_LDA1(At, 1); PG8_STAGE(PG8_SB(1, 0), b3, RB, lb2); PG8_STAGE(PG8_SB(1, 1), b3 + 128u * lb2, RB, lb2); PG8_STAGE(PG8_SA(1, 0), a3, RA, la2);
            PG8_WAIT_V(8); PG8_WAIT_L(0); PG8_BAR; if (!halfu) { PG8_MMA1(0, At, B0); PG8_MMA1(1, At, B1); } PG8_BAR; PG8_SCHED;
        }
        if (wr == 0) PG8_BAR;
        E(acc, cur, wr, wc, fr, fq);
        if (!has_next) break;
#pragma unroll
        for (int a = 0; a < 2; ++a)
#pragma unroll
            for (int b = 0; b < 2; ++b)
#pragma unroll
                for (int m = 0; m < 4; ++m)
#pragma unroll
                    for (int n = 0; n < 2; ++n) acc[a][b][m][n] = (f32x4){0.f, 0.f, 0.f, 0.f};
        cur = nxt; cA = nA; cB = nB; cla = nla; clb = nlb; ++ui;
        if (wr == 1) PG8_BAR;
    }
    PG8_WAIT_V(0);
    PG8_BAR;
#undef PG8_SA
#undef PG8_SB
#undef PG8_STAGE
#undef PG8_LDA
#undef PG8_LDA1
#undef PG8_MMA1
#undef PG8_STAGE_A1
#undef PG8_LDB
#undef PG8_MMA
#undef PG8_WAIT_V
#undef PG8_WAIT_L
#undef PG8_BAR
#undef PG8_SCHED
}

enum Kind { K_SWIGLU = 0, K_F32, K_QK, K_G, K_U, K_GATES, K_VT, K_GVT, K_KT, K_SC_P, K_SC_S, K_PV_P, K_PV_S, K_STATE, K_SPATIAL, K_MERGE0, K_MERGE1, K_SWIGLU_H   };
static_assert(K_SWIGLU_H == UNIT_HALF_KIND, "kind id used by the engine");

__device__ __forceinline__ void epi_swiglu(EPI_ARGS, bf16_t* out) {
    const bool halfu = u.kind == K_SWIGLU_H;
    const int row0 = u.pm * 256 + (halfu ? u.aux : 0) + wr * 64 + fr, col0 = u.pn * 128 + wc * 32 + 8 * fq;
#pragma unroll
    for (int ai = 0; ai < 2; ++ai)
#pragma unroll
        for (int m = 0; m < 4; ++m) { if (ai == 1 && halfu) continue;
            const f32x4 o0 = silu4(acc[ai][0][m][0]) * acc[ai][1][m][0], o1 = silu4(acc[ai][0][m][1]) * acc[ai][1][m][1];
            *(u32x4*)(out + (size_t)(row0 + ai * 128 + m * 16) * FF + col0) = pack8(o0, o1);
        }
}
__device__ __forceinline__ void epi_f32(EPI_ARGS, bf16_t* out, int ld) {
    const int row0 = u.pm * 256 + wr * 64 + fr, col0 = u.pn * 256 + wc * 32 + 8 * fq;
#pragma unroll
    for (int ai = 0; ai < 2; ++ai)
#pragma unroll
        for (int m = 0; m < 4; ++m) { bf16_t* rp = out + (size_t)(row0 + ai * 128 + m * 16) * ld + col0;
#pragma unroll
            for (int bj = 0; bj < 2; ++bj) *(u32x4*)(rp + bj * 128) = pack8(acc[ai][bj][m][0], acc[ai][bj][m][1]); }
}
template <int ACT> __device__ __forceinline__ void epi_act(EPI_ARGS, bf16_t* out, int ld, int colbase) {
    const int row0 = u.pm * 256 + wr * 64 + fr, col0 = colbase + wc * 32 + 8 * fq;
#pragma unroll
    for (int ai = 0; ai < 2; ++ai)
#pragma unroll
        for (int m = 0; m < 4; ++m) { bf16_t* rp = out + (size_t)(row0 + ai * 128 + m * 16) * ld + col0;
#pragma unroll
            for (int bj = 0; bj < 2; ++bj) { f32x4 v0 = acc[ai][bj][m][0], v1 = acc[ai][bj][m][1];
                if (ACT == 0) { v0 = silu4(v0); v1 = silu4(v1); } else if (ACT == 1) { v0 = gelu4(v0); v1 = gelu4(v1); } else { v0 = sigm4(v0); v1 = sigm4(v1); }
                *(u32x4*)(rp + bj * 128) = pack8(v0, v1); } }
}
__device__ __forceinline__ void epi_qk(EPI_ARGS, bf16_t* dst, float scale, const float* rope) {
    const int hp = u.aux, o0 = wc * 32 + 8 * fq, head = hp * 2 + (o0 >> 6), p0 = o0 & 63;
    const bool do_rope = u.pm >= 32;
#pragma unroll
    for (int ai = 0; ai < 2; ++ai) {
        f32x4 cs[4][4];
        if (do_rope) {
#pragma unroll
            for (int m = 0; m < 4; ++m) { const int pos = (u.pm * 256 + ai * 128 + wr * 64 + m * 16 + fr - MP) & 1023; const f32x4* cp = (const f32x4*)(rope + ((size_t)pos * 64 + p0) * 2);
                cs[m][0] = cp[0]; cs[m][1] = cp[1]; cs[m][2] = cp[2]; cs[m][3] = cp[3]; } }
#pragma unroll
        for (int m = 0; m < 4; ++m) {
            const int row = u.pm * 256 + ai * 128 + wr * 64 + m * 16 + fr;
            f32x4 x1a = acc[ai][0][m][0] * scale, x1b = acc[ai][0][m][1] * scale, x2a = acc[ai][1][m][0] * scale, x2b = acc[ai][1][m][1] * scale;
            if (do_rope) {
                const f32x4 c0 = cs[m][0], c1 = cs[m][1], c2 = cs[m][2], c3 = cs[m][3];
                const f32x4 ca = (f32x4){c0[0], c0[2], c1[0], c1[2]}, sa = (f32x4){c0[1], c0[3], c1[1], c1[3]};
                const f32x4 cb = (f32x4){c2[0], c2[2], c3[0], c3[2]}, sb = (f32x4){c2[1], c2[3], c3[1], c3[3]};
                const f32x4 y1a = x1a * ca - x2a * sa, y2a = x1a * sa + x2a * ca, y1b = x1b * cb - x2b * sb, y2b = x1b * sb + x2b * cb;
                x1a = y1a; x2a = y2a; x1b = y1b; x2b = y2b;
            }
            bf16_t* rp = dst + (size_t)row * 512 + head * 128 + p0;
            *(u32x4*)rp = pack8(x1a, x1b); *(u32x4*)(rp + 64) = pack8(x2a, x2b);
        }
    }
}
__device__ __forceinline__ void epi_vt(EPI_ARGS, bf16_t* vtp, bf16_t* vts) {
    const int wt = u.pm, tt = u.pn, c0 = wc * 32 + 8 * fq;
#pragma unroll
    for (int ai = 0; ai < 2; ++ai)
#pragma unroll
        for (int m = 0; m < 4; ++m) { const int vrow = wt * 256 + ai * 128 + wr * 64 + m * 16 + fr;
            bf16_t* rp;
            if (tt < 32) rp = vtp + (size_t)vrow * LD_VTP + tt * 256 + c0;
            else { const int b = (tt - 32) >> 2, pos0 = ((tt - 32) & 3) * 256 + c0; rp = vts + ((size_t)b * 1024 + vrow) * 1280 + pos0; }
#pragma unroll
            for (int bj = 0; bj < 2; ++bj) *(u32x4*)(rp + bj * 128) = pack8(acc[ai][bj][m][0], acc[ai][bj][m][1]); }
}
__device__ __forceinline__ void epi_gvt(EPI_ARGS, bf16_t* gvt) {
    const int wt = u.pm - 4, tt = u.pn, c0 = wc * 32 + 8 * fq;
#pragma unroll
    for (int ai = 0; ai < 2; ++ai)
#pragma unroll
        for (int m = 0; m < 4; ++m) { const int ch = wt * 256 + ai * 128 + wr * 64 + m * 16 + fr; bf16_t* rp = gvt + (size_t)ch * LD_GVT + tt * 256 + c0;
#pragma unroll
            for (int bj = 0; bj < 2; ++bj) *(u32x4*)(rp + bj * 128) = pack8(gelu4(acc[ai][bj][m][0]), gelu4(acc[ai][bj][m][1])); }
}
__device__ __forceinline__ void epi_kt(EPI_ARGS, bf16_t* kt, const float* decay) {
    const int hp = u.pm, tt = u.pn, head = hp * 2 + wr, c0 = wc * 32 + 8 * fq;
    const float lf = lg2_decay(decay, 0, head), lb = lg2_decay(decay, 1, head);
    f32x4 wf[2][2], wb[2][2];
#pragma unroll
    for (int bj = 0; bj < 2; ++bj)
#pragma unroll
        for (int n = 0; n < 2; ++n)
#pragma unroll
            for (int j = 0; j < 4; ++j) { const float t = (float)(bj * 128 + c0 + 4 * n + j); wf[bj][n][j] = __builtin_amdgcn_exp2f(lf * (255.f - t)); wb[bj][n][j] = __builtin_amdgcn_exp2f(lb * t); }
#pragma unroll
    for (int ai = 0; ai < 2; ++ai)
#pragma unroll
        for (int m = 0; m < 4; ++m) { const int dim = ai * 64 + m * 16 + fr;
            bf16_t* rf = kt + ((size_t)((head * 2 + 0) * 128 + dim)) * LD_KT + tt * 256 + c0; bf16_t* rb = rf + (size_t)128 * LD_KT;
#pragma unroll
            for (int bj = 0; bj < 2; ++bj) {
                *(u32x4*)(rf + bj * 128) = pack8(acc[ai][bj][m][0] * wf[bj][0], acc[ai][bj][m][1] * wf[bj][1]);
                *(u32x4*)(rb + bj * 128) = pack8(acc[ai][bj][m][0] * wb[bj][0], acc[ai][bj][m][1] * wb[bj][1]); } }
}
__device__ __forceinline__ void epi_scores(EPI_ARGS, bf16_t* pbase, int ldp, int q0, int k0, float lf, float lb) {
    const int c0 = wc * 32 + 8 * fq; const int d0 = q0 - k0; const float pf = d0 > 0 ? (float)d0 : 0.f, pb = d0 < 0 ? (float)(-d0) : 0.f;
#pragma unroll
    for (int bj = 0; bj < 2; ++bj) {
        f32x4 cf[2], cb[2]; const int cc = bj * 128 + c0;
#pragma unroll
        for (int n = 0; n < 2; ++n)
#pragma unroll
            for (int j = 0; j < 4; ++j) { const float ki = (float)(cc + 4 * n + j); cf[n][j] = __builtin_amdgcn_exp2f(-lf * ki); cb[n][j] = __builtin_amdgcn_exp2f(lb * (pb + ki)); }
#pragma unroll
        for (int ai = 0; ai < 2; ++ai)
#pragma unroll
            for (int m = 0; m < 4; ++m) { const int qi = ai * 128 + wr * 64 + m * 16 + fr;
                const float rf = __builtin_amdgcn_exp2f(lf * (pf + (float)qi)), rb = __builtin_amdgcn_exp2f(-lb * (float)qi); const int dq = d0 + qi - cc;
                f32x4 o[2];
#pragma unroll
                for (int n = 0; n < 2; ++n)
#pragma unroll
                    for (int j = 0; j < 4; ++j) { const int dlt = dq - (4 * n + j); const float w = dlt > 0 ? rf * cf[n][j] : (dlt < 0 ? rb * cb[n][j] : 2.0f); o[n][j] = acc[ai][bj][m][n][j] * w; }
                *(u32x4*)(pbase + (size_t)(q0 + qi) * ldp + k0 + cc) = pack8(o[0], o[1]);
                asm volatile("" ::: "memory"); }
    }
}
__device__ __forceinline__ void epi_pv(EPI_ARGS, LAS unsigned char* xl, bf16_t* gbuf, const float* g_ret, int tok0, int h) {
    LAS f32x2* P = (LAS f32x2*)xl;
#pragma unroll
    for (int ai = 0; ai < 2; ++ai)
#pragma unroll
        for (int m = 0; m < 4; ++m) { float s = 0.f, q = 0.f;
#pragma unroll
            for (int bj = 0; bj < 2; ++bj)
#pragma unroll
                for (int n = 0; n < 2; ++n) { const f32x4 x = acc[ai][bj][m][n]; s += (x[0] + x[1]) + (x[2] + x[3]); q += (x[0] * x[0] + x[1] * x[1]) + (x[2] * x[2] + x[3] * x[3]); }
            s += __shfl_xor(s, 16); s += __shfl_xor(s, 32); q += __shfl_xor(q, 16); q += __shfl_xor(q, 32);
            if (fq == 0) P[(ai * 128 + wr * 64 + m * 16 + fr) * 4 + wc] = (f32x2){s, q}; }
    WG_BAR();
    const int e0 = wc * 32 + 8 * fq;
    bf16_t* gp = gbuf + (size_t)(tok0 + wr * 64 + fr) * D + h * 256 + e0;
    f32x4 gr[2][2];
#pragma unroll
    for (int bj = 0; bj < 2; ++bj) { gr[bj][0] = *(const f32x4*)(g_ret + h * 256 + bj * 128 + e0); gr[bj][1] = *(const f32x4*)(g_ret + h * 256 + bj * 128 + e0 + 4); }
#pragma unroll
    for (int ai = 0; ai < 2; ++ai) {
        u32x4 gv[4][2];
#pragma unroll
        for (int m = 0; m < 4; ++m)
#pragma unroll
            for (int bj = 0; bj < 2; ++bj) gv[m][bj] = *(const u32x4*)(gp + (size_t)(ai * 128 + m * 16) * D + bj * 128);
#pragma unroll
        for (int m = 0; m < 4; ++m) { const int r = ai * 128 + wr * 64 + m * 16 + fr;
            const f32x2 pa = P[r * 4 + 0], pb = P[r * 4 + 1], pc = P[r * 4 + 2], pd = P[r * 4 + 3];
            const float mean = ((pa.x + pb.x) + (pc.x + pd.x)) * (1.f / 256.f); float var = ((pa.y + pb.y) + (pc.y + pd.y)) * (1.f / 256.f) - mean * mean; var = var > 0.f ? var : 0.f;
            const float rstd = 1.0f / sqrtf(var + EPS);
#pragma unroll
            for (int bj = 0; bj < 2; ++bj) { f32x4 s0, s1; unpack8(gv[m][bj], s0, s1);
                const f32x4 o0 = (acc[ai][bj][m][0] - mean) * rstd * gr[bj][0] * s0, o1 = (acc[ai][bj][m][1] - mean) * rstd * gr[bj][1] * s1;
                *(u32x4*)(gp + (size_t)(ai * 128 + m * 16) * D + bj * 128) = pack8(o0, o1); } }
    }
    WG_BAR();
}
__device__ __forceinline__ void epi_state(EPI_ARGS, float* out) {
    const int bh = u.aux, e0 = wc * 32 + 8 * fq;
#pragma unroll
    for (int ai = 0; ai < 2; ++ai) { float* sb = out + (size_t)M * D + (size_t)ai * (32 * 4 * 128 * 256) + (size_t)bh * (128 * 256);
#pragma unroll
        for (int m = 0; m < 4; ++m) { float* rp = sb + (size_t)(wr * 64 + m * 16 + fr) * 256 + e0;
#pragma unroll
            for (int bj = 0; bj < 2; ++bj) { *(f32x4*)(rp + bj * 128) = acc[ai][bj][m][0]; *(f32x4*)(rp + bj * 128 + 4) = acc[ai][bj][m][1]; } } }
}
__device__ __forceinline__ void epi_spatial(EPI_ARGS, bf16_t* ubuf, const float* b_sp) {
    const int cp = u.pm, g = u.pn, c0 = wc * 32 + 8 * fq;
    bf16_t* up = ubuf + (size_t)(cp * 256 + wr * 64 + fr) * D + g * 256 + c0;
#pragma unroll
    for (int ai = 0; ai < 2; ++ai) {
        u32x4 uv[4][2]; float bs[4];
#pragma unroll
        for (int m = 0; m < 4; ++m) { bs[m] = b_sp[g * 128 + ((wr * 64 + m * 16 + fr) & 127)];
#pragma unroll
            for (int bj = 0; bj < 2; ++bj) uv[m][bj] = *(const u32x4*)(up + (size_t)(ai * 128 + m * 16) * D + bj * 128); }
#pragma unroll
        for (int m = 0; m < 4; ++m)
#pragma unroll
            for (int bj = 0; bj < 2; ++bj) { f32x4 u0, u1; unpack8(uv[m][bj], u0, u1);
                *(u32x4*)(up + (size_t)(ai * 128 + m * 16) * D + bj * 128) = pack8(u0 * (acc[ai][bj][m][0] + bs[m]), u1 * (acc[ai][bj][m][1] + bs[m])); }
    }
}
__device__ __forceinline__ void epi_merge(EPI_ARGS, int kh, const bf16_t* gates, float* tmp, bf16_t* merged) {
    const int row0 = u.pm * 256 + wr * 64 + fr, col0 = u.pn * 256 + wc * 32 + 8 * fq;
#pragma unroll
    for (int ai = 0; ai < 2; ++ai)
#pragma unroll
      for (int mh = 0; mh < 2; ++mh) {
        u32x4 gv[2][2]; f32x4 tv[2][2][2];
#pragma unroll
        for (int mm = 0; mm < 2; ++mm)
#pragma unroll
            for (int bj = 0; bj < 2; ++bj) { const size_t row = (size_t)(row0 + ai * 128 + (mh * 2 + mm) * 16);
                gv[mm][bj] = *(const u32x4*)(gates + row * 2048 + kh * 1024 + col0 + bj * 128);
                if (kh) { const float* tp = tmp + row * D + col0 + bj * 128; tv[mm][bj][0] = *(const f32x4*)tp; tv[mm][bj][1] = *(const f32x4*)(tp + 4); } }
#pragma unroll
        for (int mm = 0; mm < 2; ++mm)
#pragma unroll
            for (int bj = 0; bj < 2; ++bj) { const int m = mh * 2 + mm; const size_t row = (size_t)(row0 + ai * 128 + m * 16); f32x4 g0, g1; unpack8(gv[mm][bj], g0, g1);
                if (kh == 0) { float* tp = tmp + row * D + col0 + bj * 128; *(f32x4*)tp = g0 * acc[ai][bj][m][0]; *(f32x4*)(tp + 4) = g1 * acc[ai][bj][m][1]; }
                else *(u32x4*)(merged + row * D + col0 + bj * 128) = pack8(tv[mm][bj][0] + g0 * acc[ai][bj][m][0], tv[mm][bj][1] + g1 * acc[ai][bj][m][1]); }
      }
}


__device__ __forceinline__ int mod_row(int row);
__device__ __forceinline__ void xchg_rows(LAS unsigned char* xl, const float (&rowss)[2][4], int pm, int pn, int wr, int wc, int fr, int fq, float* slots, unsigned* cnt) {
    LAS float* Pl = (LAS float*)xl; LAS float* S = (LAS float*)(xl + 4096);
    if (fq == 0) {
#pragma unroll
        for (int ai = 0; ai < 2; ++ai)
#pragma unroll
            for (int m = 0; m < 4; ++m) Pl[(ai * 128 + wr * 64 + m * 16 + fr) * 4 + wc] = rowss[ai][m]; }
    WG_BAR();
    const int tid = threadIdx.x;
    if (tid < 256) { const float t = (Pl[tid * 4 + 0] + Pl[tid * 4 + 1]) + (Pl[tid * 4 + 2] + Pl[tid * 4 + 3]);
        __hip_atomic_store(slots + ((size_t)(pm * 256 + tid)) * 4 + pn, t, __ATOMIC_RELAXED, __HIP_MEMORY_SCOPE_AGENT); }
    asm volatile("s_waitcnt vmcnt(0)" ::: "memory");
    WG_BAR();
    if (tid == 0) { unsigned* c = cnt + 16 * pm; __hip_atomic_fetch_add(c, 1u, __ATOMIC_RELAXED, __HIP_MEMORY_SCOPE_AGENT);
        unsigned sp = 0; while (__hip_atomic_load(c, __ATOMIC_RELAXED, __HIP_MEMORY_SCOPE_AGENT) < 4u) { __builtin_amdgcn_s_sleep(2); if (++sp > (1u << 22)) break; }
        __builtin_amdgcn_fence(__ATOMIC_ACQUIRE, "agent"); asm volatile("s_waitcnt vmcnt(0)" ::: "memory"); }
    WG_BAR();
    if (tid < 256) { float* sl = slots + ((size_t)(pm * 256 + tid)) * 4;
        const float t0 = __hip_atomic_load(sl + 0, __ATOMIC_RELAXED, __HIP_MEMORY_SCOPE_AGENT), t1 = __hip_atomic_load(sl + 1, __ATOMIC_RELAXED, __HIP_MEMORY_SCOPE_AGENT),
                    t2 = __hip_atomic_load(sl + 2, __ATOMIC_RELAXED, __HIP_MEMORY_SCOPE_AGENT), t3 = __hip_atomic_load(sl + 3, __ATOMIC_RELAXED, __HIP_MEMORY_SCOPE_AGENT);
        S[tid] = 1.0f / sqrtf(((t0 + t1) + (t2 + t3)) * (1.f / D) + EPS); }
    WG_BAR();
}
__device__ __forceinline__ void row_ssq(const f32x4 (&acc)[2][2][4][2], float (&rowss)[2][4]) {
#pragma unroll
    for (int ai = 0; ai < 2; ++ai)
#pragma unroll
        for (int m = 0; m < 4; ++m) { float s = 0.f;
#pragma unroll
            for (int bj = 0; bj < 2; ++bj)
#pragma unroll
                for (int n = 0; n < 2; ++n) { const f32x4 x = acc[ai][bj][m][n]; s += (x[0] * x[0] + x[1] * x[1]) + (x[2] * x[2] + x[3] * x[3]); }
            s += __shfl_xor(s, 16); s += __shfl_xor(s, 32); rowss[ai][m] = s; }
}
template <bool SRC_IN, bool HAS_H>
__device__ __forceinline__ void epi_norm(f32x4 (&acc)[2][2][4][2], const Unit& u, int wr, int wc, int fr, int fq, LAS unsigned char* xl, const Params& p,
                                         float coef, int ipost, int ig, bf16_t* hout, int ipre, int ish, int isc, int bank) {
    const LAS float* S = (const LAS float*)(xl + 4096);
    float* slots = (float*)(p.ws + WS_XS); unsigned* cnt = (unsigned*)(p.ws + WS_CNT);
    const int rowb = u.pm * 256 + wr * 64 + fr, colb = u.pn * 256 + wc * 32 + 8 * fq;
    const float* mr = (const float*)(p.ws + WS_MOD) + (size_t)mod_row(u.pm * 256) * (NMOD * D);
    const float* xsrc = SRC_IN ? (u.pm < 32 ? p.x_prompt : p.x_sample - (size_t)MP * D) : p.out;
    float rowss[2][4];
    row_ssq(acc, rowss);
    xchg_rows(xl, rowss, u.pm, u.pn, wr, wc, fr, fq, slots, cnt + bank * 1024);
    {
        f32x4 gpo[2][2], mg[2][2];
#pragma unroll
        for (int bj = 0; bj < 2; ++bj)
#pragma unroll
            for (int n = 0; n < 2; ++n) { gpo[bj][n] = *(const f32x4*)(p.g_norm + ipost * D + colb + bj * 128 + 4 * n) * coef; mg[bj][n] = *(const f32x4*)(mr + ig * D + colb + bj * 128 + 4 * n); }
#pragma unroll
        for (int ai = 0; ai < 2; ++ai)
#pragma unroll
            for (int mh = 0; mh < 2; ++mh) {
                f32x4 xv[2][2][2];
#pragma unroll
                for (int mm = 0; mm < 2; ++mm)
#pragma unroll
                    for (int bj = 0; bj < 2; ++bj) { const float* xp = xsrc + (size_t)(rowb + ai * 128 + (mh * 2 + mm) * 16) * D + colb + bj * 128; xv[mm][bj][0] = *(const f32x4*)xp; xv[mm][bj][1] = *(const f32x4*)(xp + 4); }
#pragma unroll
                for (int mm = 0; mm < 2; ++mm) { const int m = mh * 2 + mm; const float rs = S[ai * 128 + wr * 64 + m * 16 + fr];
#pragma unroll
                    for (int bj = 0; bj < 2; ++bj) { float* op = p.out + (size_t)(rowb + ai * 128 + m * 16) * D + colb + bj * 128;
#pragma unroll
                        for (int n = 0; n < 2; ++n) { acc[ai][bj][m][n] = xv[mm][bj][n] + mg[bj][n] * (acc[ai][bj][m][n] * rs * gpo[bj][n]); *(f32x4*)(op + 4 * n) = acc[ai][bj][m][n]; } } }
            }
    }
    if (HAS_H) {
        row_ssq(acc, rowss);
        xchg_rows(xl, rowss, u.pm, u.pn, wr, wc, fr, fq, slots + (size_t)M * 4, cnt + (bank + 1) * 1024);
        f32x4 gpr[2][2], msc[2][2], msh[2][2];
#pragma unroll
        for (int bj = 0; bj < 2; ++bj)
#pragma unroll
            for (int n = 0; n < 2; ++n) { gpr[bj][n] = *(const f32x4*)(p.g_norm + ipre * D + colb + bj * 128 + 4 * n); msc[bj][n] = *(const f32x4*)(mr + isc * D + colb + bj * 128 + 4 * n) + 1.0f; msh[bj][n] = *(const f32x4*)(mr + ish * D + colb + bj * 128 + 4 * n); }
#pragma unroll
        for (int ai = 0; ai < 2; ++ai)
#pragma unroll
            for (int m = 0; m < 4; ++m) { const float rs = S[ai * 128 + wr * 64 + m * 16 + fr];
#pragma unroll
                for (int bj = 0; bj < 2; ++bj) { const f32x4 o0 = acc[ai][bj][m][0] * rs * gpr[bj][0] * msc[bj][0] + msh[bj][0], o1 = acc[ai][bj][m][1] * rs * gpr[bj][1] * msc[bj][1] + msh[bj][1];
                    *(u32x4*)(hout + (size_t)(rowb + ai * 128 + m * 16) * D + colb + bj * 128) = pack8(o0, o1); } }
    }
}


__device__ __forceinline__ int trow192(int ai, int wr, int m, int fr) { return ai ? 128 + wr * 32 + m * 16 + fr : wr * 64 + m * 16 + fr; }
__device__ __forceinline__ void xchg_rows192(LAS unsigned char* xl, const float (&rowss)[2][4], int pm, int pn, int wr, int wc, int fr, int fq, float* slots, unsigned* cnt) {
    LAS float* Pl = (LAS float*)xl; LAS float* S = (LAS float*)(xl + 4096);
    if (fq == 0) {
#pragma unroll
        for (int ai = 0; ai < 2; ++ai)
#pragma unroll
            for (int m = 0; m < (ai ? 2 : 4); ++m) Pl[trow192(ai, wr, m, fr) * 4 + wc] = rowss[ai][m]; }
    WG_BAR();
    const int tid = threadIdx.x;
    if (tid < 192) { const float t = (Pl[tid * 4 + 0] + Pl[tid * 4 + 1]) + (Pl[tid * 4 + 2] + Pl[tid * 4 + 3]);
        __hip_atomic_store(slots + ((size_t)(pm * 192 + tid)) * 4 + pn, t, __ATOMIC_RELAXED, __HIP_MEMORY_SCOPE_AGENT); }
    asm volatile("s_waitcnt vmcnt(0)" ::: "memory");
    WG_BAR();
    if (tid == 0) { unsigned* c = cnt + 16 * pm; __hip_atomic_fetch_add(c, 1u, __ATOMIC_RELAXED, __HIP_MEMORY_SCOPE_AGENT);
        unsigned sp = 0; while (__hip_atomic_load(c, __ATOMIC_RELAXED, __HIP_MEMORY_SCOPE_AGENT) < 4u) { __builtin_amdgcn_s_sleep(2); if (++sp > (1u << 22)) break; }
        __builtin_amdgcn_fence(__ATOMIC_ACQUIRE, "agent"); asm volatile("s_waitcnt vmcnt(0)" ::: "memory"); }
    WG_BAR();
    if (tid < 192) { float* sl = slots + ((size_t)(pm * 192 + tid)) * 4;
        const float t0 = __hip_atomic_load(sl + 0, __ATOMIC_RELAXED, __HIP_MEMORY_SCOPE_AGENT), t1 = __hip_atomic_load(sl + 1, __ATOMIC_RELAXED, __HIP_MEMORY_SCOPE_AGENT),
                    t2 = __hip_atomic_load(sl + 2, __ATOMIC_RELAXED, __HIP_MEMORY_SCOPE_AGENT), t3 = __hip_atomic_load(sl + 3, __ATOMIC_RELAXED, __HIP_MEMORY_SCOPE_AGENT);
        S[tid] = 1.0f / sqrtf(((t0 + t1) + (t2 + t3)) * (1.f / D) + EPS); }
    WG_BAR();
}
__device__ __forceinline__ void row_ssq192(const f32x4 (&acc)[2][2][4][2], float (&rowss)[2][4]) {
#pragma unroll
    for (int ai = 0; ai < 2; ++ai)
#pragma unroll
        for (int m = 0; m < (ai ? 2 : 4); ++m) { float s = 0.f;
#pragma unroll
            for (int bj = 0; bj < 2; ++bj)
#pragma unroll
                for (int n = 0; n < 2; ++n) { const f32x4 x = acc[ai][bj][m][n]; s += (x[0] * x[0] + x[1] * x[1]) + (x[2] * x[2] + x[3] * x[3]); }
            s += __shfl_xor(s, 16); s += __shfl_xor(s, 32); rowss[ai][m] = s; }
}
__device__ __forceinline__ const float* xrow_in(const Params& p, int row);
template <bool SRC_IN, bool HAS_H>
__device__ __forceinline__ void epi_norm192(f32x4 (&acc)[2][2][4][2], const Unit& u, int wr, int wc, int fr, int fq, LAS unsigned char* xl, const Params& p,
                                            float coef, int ipost, int ig, bf16_t* hout, int ipre, int ish, int isc, int bank) {
    const LAS float* S = (const LAS float*)(xl + 4096);
    float* slots = (float*)(p.ws + WS_XS); unsigned* cnt = (unsigned*)(p.ws + WS_CNT);
    const int row0 = u.pm * 192, colb = u.pn * 256 + wc * 32 + 8 * fq;
    const float* modb = (const float*)(p.ws + WS_MOD);
    float rowss[2][4];
    row_ssq192(acc, rowss);
    {
        f32x4 gpo[2][2], xv[2][2][2], mgv[2][2][2];
#pragma unroll
        for (int bj = 0; bj < 2; ++bj)
#pragma unroll
            for (int n = 0; n < 2; ++n) gpo[bj][n] = *(const f32x4*)(p.g_norm + ipost * D + colb + bj * 128 + 4 * n) * coef;
#define EPN_LOADB(AI, MH) do { _Pragma("unroll") for (int mm = 0; mm < 2; ++mm) { const int grow = row0 + trow192(AI, wr, (MH) * 2 + mm, fr); \
            const float* xr = (SRC_IN ? xrow_in(p, grow) : p.out + (size_t)grow * D) + colb; const float* mr = modb + (size_t)mod_row(grow) * (NMOD * D) + ig * D + colb; \
            _Pragma("unroll") for (int bj = 0; bj < 2; ++bj) { xv[mm][bj][0] = *(const f32x4*)(xr + bj * 128); xv[mm][bj][1] = *(const f32x4*)(xr + bj * 128 + 4); mgv[mm][bj][0] = *(const f32x4*)(mr + bj * 128); mgv[mm][bj][1] = *(const f32x4*)(mr + bj * 128 + 4); } } } while (0)
#define EPN_APPLYB(AI, MH) do { _Pragma("unroll") for (int mm = 0; mm < 2; ++mm) { const int m = (MH) * 2 + mm, tr = trow192(AI, wr, m, fr); const float rs = S[tr]; float* op = p.out + (size_t)(row0 + tr) * D + colb; \
            _Pragma("unroll") for (int bj = 0; bj < 2; ++bj) _Pragma("unroll") for (int n = 0; n < 2; ++n) { acc[AI][bj][m][n] = xv[mm][bj][n] + mgv[mm][bj][n] * gpo[bj][n] * (acc[AI][bj][m][n] * rs); *(f32x4*)(op + bj * 128 + 4 * n) = acc[AI][bj][m][n]; } } } while (0)
        EPN_LOADB(0, 0);
        xchg_rows192(xl, rowss, u.pm, u.pn, wr, wc, fr, fq, slots, cnt + bank * 1024);
        EPN_APPLYB(0, 0); EPN_LOADB(0, 1); EPN_APPLYB(0, 1); EPN_LOADB(1, 0); EPN_APPLYB(1, 0);
#undef EPN_LOADB
#undef EPN_APPLYB
    }
    if (HAS_H) {
        row_ssq192(acc, rowss);
        f32x4 gpr[2][2];
#pragma unroll
        for (int bj = 0; bj < 2; ++bj)
#pragma unroll
            for (int n = 0; n < 2; ++n) gpr[bj][n] = *(const f32x4*)(p.g_norm + ipre * D + colb + bj * 128 + 4 * n);
        xchg_rows192(xl, rowss, u.pm, u.pn, wr, wc, fr, fq, slots + (size_t)M * 4, cnt + (bank + 1) * 1024);
#pragma unroll
        for (int ai = 0; ai < 2; ++ai)
#pragma unroll
            for (int m = 0; m < (ai ? 2 : 4); ++m) { const int tr = trow192(ai, wr, m, fr), grow = row0 + tr; const float rs = S[tr];
                const float* mr = modb + (size_t)mod_row(grow) * (NMOD * D) + colb;
#pragma unroll
                for (int bj = 0; bj < 2; ++bj) { const f32x4 sc0 = *(const f32x4*)(mr + isc * D + bj * 128), sc1 = *(const f32x4*)(mr + isc * D + bj * 128 + 4), sh0 = *(const f32x4*)(mr + ish * D + bj * 128), sh1 = *(const f32x4*)(mr + ish * D + bj * 128 + 4);
                    const f32x4 o0 = acc[ai][bj][m][0] * rs * gpr[bj][0] * (sc0 + 1.0f) + sh0, o1 = acc[ai][bj][m][1] * rs * gpr[bj][1] * (sc1 + 1.0f) + sh1;
                    *(u32x4*)(hout + (size_t)grow * D + colb + bj * 128) = pack8(o0, o1); } }
    }
}
struct SchedT192 {
    const char* A; const char* B; unsigned lda, ldb; int nt, G, c;
    __device__ __forceinline__ bool next(int i, Unit& u) const {
        const long L = (long)i * G + c; if (L >= 256) return false;
        int pm, pn; tile_map((int)L, 64, 4, pm, pn);
        u.a = A + (size_t)pm * 192 * lda; u.b = B + (size_t)pn * 256 * ldb; u.lda = lda; u.ldb = ldb; u.nt = nt; u.kind = K_F32; u.pm = pm; u.pn = pn; u.aux = 0; return true;
    }
};
template <int PH> struct Epi {
    Params p; LAS unsigned char* xl;
    __device__ __forceinline__ void operator()(f32x4 (&acc)[2][2][4][2], const Unit& u, int wr, int wc, int fr_, int fq_) const {
        unsigned char* ws = p.ws;
        int fr = fr_, fq = fq_; asm volatile("" : "+v"(fr), "+v"(fq));
        if constexpr (PH == 2) { epi_swiglu(acc, u, wr, wc, fr, fq, (bf16_t*)(ws + WS_ACT)); return; }
        if constexpr (PH == 3) { epi_norm192<true, true>(acc, u, wr, wc, fr, fq, xl, p, 0.5f, 1, 2, (bf16_t*)((unsigned char*)p.out + OUT_H2), 2, 3, 4, 0); return; }
        if constexpr (PH == 9) { epi_norm192<false, true>(acc, u, wr, wc, fr, fq, xl, p, 1.0f, 3, 5, (bf16_t*)(ws + WS_H3), 4, 6, 7, 2); return; }
        if constexpr (PH == 12) { epi_norm192<false, false>(acc, u, wr, wc, fr, fq, xl, p, 0.5f, 5, 8, nullptr, 0, 0, 0, 4); return; }
        const int kind = PH == 5 ? (u.kind < K_QK ? K_QK : (u.kind > K_KT ? K_KT : u.kind)) : PH == 6 ? ((u.kind == K_VT || u.kind == K_KT) ? u.kind : K_SC_P) : PH == 7 ? (u.kind < K_PV_P ? K_PV_P : (u.kind > K_SPATIAL ? K_SPATIAL : u.kind)) : (u.kind == K_MERGE0 ? K_MERGE0 : K_MERGE1);
        switch (kind) {
        case K_SWIGLU: epi_swiglu(acc, u, wr, wc, fr, fq, (bf16_t*)(ws + WS_ACT)); break;
        case K_QK: epi_qk(acc, u, wr, wc, fr, fq, (bf16_t*)(ws + (u.pn < 2 ? WS_Q : WS_K)), u.pn < 2 ? 0.08838834764831845f : 1.0f, (const float*)(ws + WS_ROPE)); break;
        case K_G: epi_act<0>(acc, u, wr, wc, fr, fq, (bf16_t*)(ws + WS_G), D, u.aux * 256); break;
        case K_U: epi_act<1>(acc, u, wr, wc, fr, fq, (bf16_t*)(ws + WS_U), D, u.aux * 256); break;
        case K_GATES: epi_act<2>(acc, u, wr, wc, fr, fq, (bf16_t*)(ws + WS_GATES), 2048, u.aux * 256); break;
        case K_VT: epi_vt(acc, u, wr, wc, fr, fq, (bf16_t*)(ws + WS_VTP), (bf16_t*)(ws + WS_VTS)); break;
        case K_GVT: epi_gvt(acc, u, wr, wc, fr, fq, (bf16_t*)(ws + WS_GVT)); break;
        case K_KT: epi_kt(acc, u, wr, wc, fr, fq, (bf16_t*)(ws + WS_KT), (const float*)(ws + WS_LG)); break;
        case K_SC_P: case K_SC_S: { const bool sm = u.kind == K_SC_S; const int bh = sm ? (u.aux >> 4) : u.aux, h = bh & 3, qi = sm ? ((u.aux >> 2) & 3) : 0, ki = sm ? (u.aux & 3) : 0;
            const float* lgt = (const float*)(ws + WS_LG);
            epi_scores(acc, u, wr, wc, fr, fq, sm ? (bf16_t*)(ws + WS_PS) + (size_t)bh * (1024 * 1280) : (bf16_t*)(ws + WS_PP) + (size_t)bh * 65536, sm ? 1280 : 256, qi * 256, ki * 256, lgt[h], lgt[4 + h]); } break;
        case K_PV_P: { const int bh = u.aux; epi_pv(acc, u, wr, wc, fr, fq, xl, (bf16_t*)(ws + WS_G), p.g_ret, (bh >> 2) * 256, bh & 3); } break;
        case K_PV_S: { const int bh = u.aux >> 2, qi = u.aux & 3; epi_pv(acc, u, wr, wc, fr, fq, xl, (bf16_t*)(ws + WS_G), p.g_ret, MP + (bh >> 2) * 1024 + qi * 256, bh & 3); } break;
        case K_STATE: epi_state(acc, u, wr, wc, fr, fq, p.out); break;
        case K_SPATIAL: epi_spatial(acc, u, wr, wc, fr, fq, (bf16_t*)(ws + WS_U), p.b_sp); break;
        case K_MERGE0: epi_merge(acc, u, wr, wc, fr, fq, 0, (const bf16_t*)(ws + WS_GATES), (float*)(ws + WS_TMP), (bf16_t*)(ws + WS_MERGED)); break;
        case K_MERGE1: epi_merge(acc, u, wr, wc, fr, fq, 1, (const bf16_t*)(ws + WS_GATES), (float*)(ws + WS_TMP), (bf16_t*)(ws + WS_MERGED)); break;
        default: break;
        }
    }
};

struct SchedSimple {
    const char* A; const char* B; unsigned lda, ldb; int nM, nN, nt, kind, aux, G, c;
    __device__ __forceinline__ bool next(int i, Unit& u) const {
        const long L = (long)i * G + c; if (L >= nM * nN) return false;
        int pm, pn; tile_map((int)L, nM, nN, pm, pn);
        u.a = A + (size_t)pm * 256 * lda; u.b = B + (size_t)pn * 256 * ldb; u.lda = lda; u.ldb = ldb; u.nt = nt; u.kind = kind; u.pm = pm; u.pn = pn; u.aux = aux; return true;
    }
};
struct SchedIn {
    const char* H; const char* W; int G, c;
    __device__ __forceinline__ bool next(int i, Unit& u) const {
        long L = (long)i * G + c; u.lda = 2048; u.ldb = 2048; u.nt = 16;
        if (L < 960) { int pm, ct; tile_map((int)L, 48, 20, pm, ct);
            int wrow, kind, aux;
            if (ct < 4) { wrow = ct * 256; kind = K_QK; aux = ct & 1; }
            else if (ct < 8) { wrow = 2048 + (ct - 4) * 256; kind = K_G; aux = ct - 4; }
            else if (ct < 12) { wrow = 3072 + (ct - 8) * 256; kind = K_U; aux = ct - 8; }
            else { wrow = 5120 + (ct - 12) * 256; kind = K_GATES; aux = ct - 12; }
            u.a = H + (size_t)pm * 256 * 2048; u.b = W + (size_t)wrow * 2048; u.kind = kind; u.pm = pm; u.pn = ct; u.aux = aux; return true; }
        L -= 960;
        if (L < 192) { int wt, tt; tile_map((int)L, 4, 48, wt, tt);
            u.a = W + (size_t)(4096 + wt * 256) * 2048; u.b = H + (size_t)tt * 256 * 2048; u.kind = K_GVT; u.pm = wt + 4; u.pn = tt; u.aux = 0; return true; }
        L -= 192;
        if (L < 128) { int wt, tt; tile_map((int)L, 4, 32, wt, tt);
            u.a = W + (size_t)(1024 + wt * 256) * 2048; u.b = H + (size_t)tt * 256 * 2048; u.kind = K_VT; u.pm = wt; u.pn = tt; u.aux = 0; return true; }
        return false;
    }
};
struct SchedScores {
    const char* Q; const char* Kb; const char* H; const char* W; int G, c;
    __device__ __forceinline__ bool fill(int L, Unit& u) const {
        const bool big = L < 128, isvt = L < 64;
        int hp, tk; tile_map(big && !isvt ? L - 64 : 0, 2, 32, hp, tk);
        const int wt = L & 3, tv = 32 + (L >> 2);
        const size_t wrow = isvt ? (size_t)(1024 + wt * 256) : (size_t)(512 + hp * 256);
        const int ttok = isvt ? tv : tk;
        const int Ls = L - 128; const bool smp = Ls < 256; const int idx = smp ? Ls : Ls - 256;
        const int bh = smp ? (idx >> 4) : idx, b = bh >> 2, h = bh & 3, qi = smp ? ((idx >> 2) & 3) : 0, ki = smp ? (idx & 3) : 0;
        const size_t qrow = smp ? (size_t)(MP + b * 1024 + qi * 256) : (size_t)(b * 256), krow = smp ? (size_t)(MP + b * 1024 + ki * 256) : (size_t)(b * 256);
        const char* sa = Q + (qrow * 512 + h * 128) * 2; const char* sb = Kb + (krow * 512 + h * 128) * 2;
        const char* ba = W + wrow * 2048; const char* bb = H + (size_t)ttok * 256 * 2048;
        u.a = big ? ba : sa; u.b = big ? bb : sb; u.lda = big ? 2048u : 1024u; u.ldb = u.lda; u.nt = big ? 16 : 2;
        u.kind = big ? (isvt ? K_VT : K_KT) : (smp ? K_SC_S : K_SC_P); u.pm = big ? (isvt ? wt : hp) : 0; u.pn = big ? ttok : 0; u.aux = big ? 0 : idx;
        return true;
    }
    __device__ __forceinline__ bool next(int i, Unit& u) const {
        if (G == 256) { if (c < 128) return i == 0 ? fill(c, u) : false; if (c < 192) return i < 2 ? fill(128 + (c - 128) * 2 + i, u) : false; return i < 4 ? fill(256 + (c - 192) * 4 + i, u) : false; }
        const long L = (long)i * G + c; return L < 512 ? fill((int)L, u) : false;
    }
};
struct SchedMix {
    const unsigned char* ws; int G, c;
    __device__ __forceinline__ bool fill(int L, Unit& u) const {
        if (L < 64) { const int bh = L >> 2, b = bh >> 2, h = bh & 3, qi = L & 3;
            u.a = (const char*)ws + WS_PS + ((size_t)(bh * 1024 + qi * 256) * 1280) * 2; u.lda = 2560; u.b = (const char*)ws + WS_VTS + ((size_t)(b * 1024 + h * 256) * 1280) * 2; u.ldb = 2560;
            u.nt = 20; u.kind = K_PV_S; u.pm = 0; u.pn = 0; u.aux = L; return true; }
        L -= 64;
        if (L < 128) { const int bh = L, b = bh >> 2, h = bh & 3;
            u.a = (const char*)ws + WS_PP + (size_t)bh * 131072; u.lda = 512; u.b = (const char*)ws + WS_VTP + ((size_t)(h * 256) * LD_VTP + b * 256) * 2; u.ldb = LD_VTP * 2;
            u.nt = 4; u.kind = K_PV_P; u.pm = 0; u.pn = 0; u.aux = bh; return true; }
        L -= 128;
        if (L < 128) { const int bh = L, b = bh >> 2, h = bh & 3;
            u.a = (const char*)ws + WS_KT + ((size_t)(h * 256) * LD_KT + b * 256) * 2; u.lda = LD_KT * 2; u.b = (const char*)ws + WS_VTP + ((size_t)(h * 256) * LD_VTP + b * 256) * 2; u.ldb = LD_VTP * 2;
            u.nt = 4; u.kind = K_STATE; u.pm = 0; u.pn = 0; u.aux = bh; return true; }
        L -= 128;
        if (L < 192) { const int cp = L >> 2, g = L & 3;
            u.a = (const char*)ws + WS_BD + (size_t)g * 131072; u.lda = 512; u.b = (const char*)ws + WS_GVT + ((size_t)(g * 256) * LD_GVT + cp * 256) * 2; u.ldb = LD_GVT * 2;
            u.nt = 4; u.kind = K_SPATIAL; u.pm = cp; u.pn = g; u.aux = 0; return true; }
        return false;
    }
    __device__ __forceinline__ bool next(int i, Unit& u) const {
        if (G >= 128) { if (c < 64) return i == 0 ? fill(c, u) : false; const long L = 64 + (long)i * (G - 64) + (c - 64); return L < 512 ? fill((int)L, u) : false; }
        const long L = (long)i * G + c; return L < 512 ? fill((int)L, u) : false;
    }
};
struct SchedSwiglu {
    const char* A; const char* B; int G, c;
    __device__ __forceinline__ bool next(int i, Unit& u) const {
        const bool sp = (G == 256); const bool halfu = sp && i == 4;
        const long L = halfu ? (long)(1024 + (c >> 1)) : (long)i * G + c;
        const bool valid = halfu ? (c < 64) : (L < (sp ? 1024 : 1056));
        int pm, pn; tile_map(valid ? (int)L : 0, 48, 22, pm, pn);
        const int ro = halfu ? (c & 1) * 128 : 0;
        u.a = A + ((size_t)pm * 256 + ro) * 2048; u.b = B + (size_t)pn * 256 * 2048; u.lda = 2048; u.ldb = 2048; u.nt = 16; u.kind = halfu ? K_SWIGLU_H : K_SWIGLU; u.pm = pm; u.pn = pn; u.aux = ro;
        return valid && (!sp || i < 5);
    }
};
struct SchedMerge {
    const unsigned char* ws; int G, c;
    __device__ __forceinline__ bool next(int i, Unit& u) const {
        const long L = (long)(i >> 1) * G + c; if (L >= 192) return false; const int kh = i & 1;
        int pm, pn; tile_map((int)L, 48, 4, pm, pn);
        u.a = (const char*)ws + (kh ? WS_U : WS_G) + (size_t)pm * 256 * 2048; u.b = (const char*)ws + (kh ? WS_WS : WS_WR) + (size_t)pn * 256 * 2048; u.lda = 2048; u.ldb = 2048; u.nt = 16;
        u.kind = kh ? K_MERGE1 : K_MERGE0; u.pm = pm; u.pn = pn; u.aux = 0; return true;
    }
};

__device__ __forceinline__ void transpose_item(const float* W, int K, int N, bf16_t* WT, int dstrow0, LAS float* scr, int k0, int n0, int lane) {
#pragma unroll
    for (int i = 0; i < 32; ++i) { const int kk = 2 * i + (lane >> 5); scr[kk * 33 + (lane & 31)] = __builtin_nontemporal_load(W + (size_t)(k0 + kk) * N + n0 + (lane & 31)); }
    LDS_WAIT();
    const int c = lane & 7;
#pragma unroll
    for (int j = 0; j < 4; ++j) { const int n = (lane >> 3) + 8 * j; const LAS float* s = scr + (8 * c) * 33 + n;
        u32x4 o; o.x = cvt_pk_bf16(s[0 * 33], s[1 * 33]); o.y = cvt_pk_bf16(s[2 * 33], s[3 * 33]); o.z = cvt_pk_bf16(s[4 * 33], s[5 * 33]); o.w = cvt_pk_bf16(s[6 * 33], s[7 * 33]);
        *(u32x4*)(WT + (size_t)(dstrow0 + n) * K + k0 + 8 * c) = o; }
    LDS_WAIT();
}
template <int MODE> __device__ __forceinline__ void conv_matrix(const float* W, int K, int N, bf16_t* WT, LAS float* scr, int gw, int NGW, int lane) {
    const int nblk = N / 32, nitems = (K / 64) * nblk;
    for (int it = gw; it < nitems; it += NGW) { const int kb = it / nblk, nb = it % nblk, n0 = nb * 32; int dr = n0;
        if (MODE == 1) { const int half = n0 / FF, cidx = n0 % FF; dr = (cidx >> 7) * 256 + half * 128 + (cidx & 127); }
        if (MODE == 2) { if (n0 < 1024) { const int seg = n0 >> 9, r = n0 & 511, head = r >> 7, dim = r & 127; dr = (seg * 2 + (head >> 1)) * 256 + (dim >> 6) * 128 + (head & 1) * 64 + (dim & 63); } }
        transpose_item(W, K, N, WT, dr, scr, kb * 64, n0, lane); }
}
__device__ __forceinline__ void conv_wkv(const float* W, bf16_t* WT, LAS float* scr, int gw, int NGW, int lane) {
    const int nblk = 1536 / 32, nitems = (D / 64) * nblk;
    for (int it = gw; it < nitems; it += NGW) { const int kb = it / nblk, nb = it % nblk, n0 = 512 + nb * 32; int dr = n0;
        if (n0 < 1024) { const int seg = n0 >> 9, r = n0 & 511, head = r >> 7, dim = r & 127; dr = (seg * 2 + (head >> 1)) * 256 + (dim >> 6) * 128 + (head & 1) * 64 + (dim & 63); }
        transpose_item(W, D, 7168, WT, dr - 512, scr, kb * 64, n0, lane); }
}
__device__ __forceinline__ const float* xrow_in(const Params& p, int row) { return row < MP ? p.x_prompt + (size_t)row * D : p.x_sample + (size_t)(row - MP) * D; }
__device__ __forceinline__ int mod_row(int row) { return row < MP ? 0 : 1 + ((row - MP) >> 10); }

template <bool HAS_F, bool HAS_H>
__device__ __forceinline__ void norm_pass(const Params& p, const float* xsrc_out  , const bf16_t* f, float coef, int ipost, int ig, bf16_t* hout, int ipre, int ish, int isc, int gw, int NGW, int lane) {
    const float* mod = (const float*)(p.ws + WS_MOD);
    f32x4 gpo[4], gpr[4], mg[4], msc[4], msh[4];
#pragma unroll
    for (int j = 0; j < 4; ++j) { if (HAS_F) gpo[j] = *(const f32x4*)(p.g_norm + ipost * D + 4 * lane + 256 * j); if (HAS_H) gpr[j] = *(const f32x4*)(p.g_norm + ipre * D + 4 * lane + 256 * j); }
    int cur_mr = -1;
    f32x4 v[4], nv[4]; u32x2 fv[4], nfv[4];
    int row = gw;
    if (row < M) { const float* xr = xsrc_out ? xsrc_out + (size_t)row * D : xrow_in(p, row);
#pragma unroll
        for (int j = 0; j < 4; ++j) { nv[j] = *(const f32x4*)(xr + 4 * lane + 256 * j); if (HAS_F) nfv[j] = *(const u32x2*)(f + (size_t)row * D + 4 * lane + 256 * j); } }
    for (; row < M; row += NGW) {
#pragma unroll
        for (int j = 0; j < 4; ++j) { v[j] = nv[j]; if (HAS_F) fv[j] = nfv[j]; }
        const int nrow = row + NGW;
        if (nrow < M) { const float* xr = xsrc_out ? xsrc_out + (size_t)nrow * D : xrow_in(p, nrow);
#pragma unroll
            for (int j = 0; j < 4; ++j) { nv[j] = *(const f32x4*)(xr + 4 * lane + 256 * j); if (HAS_F) nfv[j] = *(const u32x2*)(f + (size_t)nrow * D + 4 * lane + 256 * j); } }
        const int mrow = mod_row(row);
        if (mrow != cur_mr) { cur_mr = mrow; const float* mr = mod + (size_t)mrow * (NMOD * D);
#pragma unroll
            for (int j = 0; j < 4; ++j) { if (HAS_F) mg[j] = *(const f32x4*)(mr + ig * D + 4 * lane + 256 * j);
                if (HAS_H) { msc[j] = *(const f32x4*)(mr + isc * D + 4 * lane + 256 * j); msh[j] = *(const f32x4*)(mr + ish * D + 4 * lane + 256 * j); } } }
        if (HAS_F) {
            f32x4 ff[4]; float ss = 0.f;
#pragma unroll
            for (int j = 0; j < 4; ++j) { ff[j] = (f32x4){__uint_as_float(fv[j].x << 16), __uint_as_float(fv[j].x & 0xffff0000u), __uint_as_float(fv[j].y << 16), __uint_as_float(fv[j].y & 0xffff0000u)};
                ss += (ff[j][0] * ff[j][0] + ff[j][1] * ff[j][1]) + (ff[j][2] * ff[j][2] + ff[j][3] * ff[j][3]); }
            const float rs = coef / sqrtf(wave_sum(ss) * (1.f / D) + EPS);
#pragma unroll
            for (int j = 0; j < 4; ++j) { v[j] = v[j] + mg[j] * (ff[j] * rs * gpo[j]); *(f32x4*)(p.out + (size_t)row * D + 4 * lane + 256 * j) = v[j]; }
        }
        if (HAS_H) {
            float ss = 0.f;
#pragma unroll
            for (int j = 0; j < 4; ++j) ss += (v[j][0] * v[j][0] + v[j][1] * v[j][1]) + (v[j][2] * v[j][2] + v[j][3] * v[j][3]);
            const float rs = 1.0f / sqrtf(wave_sum(ss) * (1.f / D) + EPS);
#pragma unroll
            for (int j = 0; j < 4; ++j) { const f32x4 o = v[j] * rs * gpr[j] * (1.0f + msc[j]) + msh[j]; u32x2 w; w.x = cvt_pk_bf16(o[0], o[1]); w.y = cvt_pk_bf16(o[2], o[3]);
                *(u32x2*)(hout + (size_t)row * D + 4 * lane + 256 * j) = w; }
        }
    }
}

#define XB_TMO      128
#define XB_XCNT(j)  (256  + 64 * (j))
#define XB_XSUB(j)  (1280 + 64 * (j))
#define XB_XGEN(j)  (2304 + 64 * (j))
#define XB_TOP      3328
#define XB_TOPGEN   3392
#define XCD_BAR_WORDS 3456
#define XB_SPIN_CAP (1u << 22)

__device__ __forceinline__ unsigned xb_ld(unsigned* p)              { return __hip_atomic_load(p, __ATOMIC_RELAXED, __HIP_MEMORY_SCOPE_AGENT); }
__device__ __forceinline__ unsigned xb_add(unsigned* p, unsigned v) { return __hip_atomic_fetch_add(p, v, __ATOMIC_RELAXED, __HIP_MEMORY_SCOPE_AGENT); }
__device__ __forceinline__ unsigned xb_xcc_id() { return (unsigned)__builtin_amdgcn_s_getreg((3 << 11) | 20) & 0xFu; }
#define XB_SPIN(cond, bar) do { unsigned _sp = 0; while (cond) { __builtin_amdgcn_s_sleep(1); \
    if ((++_sp & 255u) == 0u) { if (xb_ld(&(bar)[XB_TMO])) break; if (_sp > XB_SPIN_CAP) { atomicAdd(&(bar)[XB_TMO], 1u); break; } } } } while (0)

struct XcdBarrier {
    unsigned* bar; unsigned x;
    volatile LAS unsigned* st;
};

__device__ __forceinline__ XcdBarrier xcd_barrier_post(unsigned* bar, volatile LAS unsigned* st) {
    XcdBarrier b; b.bar = bar; b.x = xb_xcc_id(); b.st = st;
    if (threadIdx.x == 0) (void)xb_add(&bar[XB_XCNT(b.x)], 1u);
    return b;
}
__device__ __forceinline__ void xcd_barrier_complete(unsigned* bar, unsigned x, unsigned& nloc, unsigned& nx) {
    const unsigned G = gridDim.x * gridDim.y * gridDim.z;
    unsigned sum, cnt, mine, sp = 0u;
    for (;;) {
        sum = 0u; cnt = 0u; mine = 0u;
#pragma unroll
        for (unsigned j = 0; j < 16; ++j) { const unsigned c = xb_ld(&bar[XB_XCNT(j)]); sum += c; cnt += (c > 0u) ? 1u : 0u; mine = (j == x) ? c : mine; }
        if (sum == G) break;
        __builtin_amdgcn_s_sleep(1);
        if ((++sp & 255u) == 0u) { if (xb_ld(&bar[XB_TMO])) break; if (sp > XB_SPIN_CAP) { atomicAdd(&bar[XB_TMO], 1u); break; } }
    }
    nloc = mine > 0u ? mine : 1u; nx = cnt > 0u ? cnt : 1u;
}

__device__ __forceinline__ void xcd_barrier(const XcdBarrier& b) {
    asm volatile("s_waitcnt vmcnt(0)" ::: "memory");
    __syncthreads();
    if (threadIdx.x == 0) {
        unsigned* bar = b.bar;
        __builtin_amdgcn_s_waitcnt(0);
        unsigned nloc = b.st[0], nx = b.st[1];
        if (nloc == 0u) { xcd_barrier_complete(bar, b.x, nloc, nx); b.st[0] = nloc; b.st[1] = nx; }
        const unsigned old = xb_add(&bar[XB_XSUB(b.x)], 1u);
        const unsigned gen = old / nloc;
        if (old + 1u == (gen + 1u) * nloc) {
            __builtin_amdgcn_fence(__ATOMIC_RELEASE, "agent");
            asm volatile("s_waitcnt vmcnt(0)" ::: "memory");
            const unsigned og = xb_add(&bar[XB_TOP], 1u);
            const unsigned tg = og / nx;
            if (og + 1u == (tg + 1u) * nx) xb_add(&bar[XB_TOPGEN], 1u);
            else XB_SPIN(xb_ld(&bar[XB_TOPGEN]) == tg, bar);
            __builtin_amdgcn_fence(__ATOMIC_ACQUIRE, "agent");
            xb_add(&bar[XB_XGEN(b.x)], 1u);
            asm volatile("s_waitcnt vmcnt(0)" ::: "memory");
        } else {
            XB_SPIN(xb_ld(&bar[XB_XGEN(b.x)]) == gen, bar);
            __builtin_amdgcn_fence(__ATOMIC_ACQUIRE, "agent");
            asm volatile("s_waitcnt vmcnt(0)" ::: "memory");
        }
    }
    __syncthreads();
}

__global__ void __launch_bounds__(512, 2) fwd_kernel(Params pa) {
    extern __shared__ __attribute__((aligned(16))) unsigned char lds_raw[];
    LAS unsigned char* lds = (LAS unsigned char*)lds_raw;
    cg::grid_group grid = cg::this_grid();
    const int G = gridDim.x, bid = blockIdx.x, NGW = G * 8, NGT = G * 512;
    const int lo = pa.ph_lo, hi = pa.ph_hi;
    typedef const __attribute__((address_space(4))) Params* KParamsPtr;
    const KParamsPtr kp = (KParamsPtr)__builtin_amdgcn_kernarg_segment_ptr();
#define LOADP KParamsPtr kq = kp; asm volatile("" : "+s"(kq)); Params p; __builtin_memcpy(&p, kq, sizeof(Params)); unsigned char* const ws = p.ws; \
    int tid_ = threadIdx.x; asm volatile("" : "+v"(tid_)); const int tid = tid_, lane = tid & 63, wave = __builtin_amdgcn_readfirstlane(tid >> 6), gw = bid * 8 + wave, gt = bid * 512 + tid; \
    LAS float* const scr = (LAS float*)(lds + wave * 16384); (void)lane; (void)gw; (void)gt; (void)scr
#ifndef PH_MASK
#define PH_MASK 0xffff
#endif
#define IN(k) (((PH_MASK >> (k)) & 1) && ((lo >> (k)) & 1))
#define SEAM(k) do { if (hi) xcd_barrier(bar); } while (0)
    if (pa.ph_hi > 1000) grid.sync();
    if (threadIdx.x < 8) ((LAS unsigned*)(lds + MISC_OFF))[threadIdx.x] = 0u;
    __syncthreads();
    XcdBarrier bar = xcd_barrier_post((unsigned*)(pa.ws + WS_BAR), (volatile LAS unsigned*)(lds + MISC_OFF));
    LAS unsigned char* const xl = lds + XL_OFF;

#ifdef NANFILL
    {
        u32x4* wsv = (u32x4*)pa.ws; const u32x4 ff = (u32x4){0xffffffffu, 0xffffffffu, 0xffffffffu, 0xffffffffu};
        const size_t lo_skip = WS_BAR / 16, hi_skip = (WS_BAR + 16384) / 16;
        for (size_t e = gt; e < WS_END / 16; e += NGT) if (e < lo_skip || e >= hi_skip) wsv[e] = ff;
        xcd_barrier(bar);
    }
#endif
    if (IN(0)) { LOADP;
        if (bid < 144) {
            LAS float* sc = (LAS float*)lds; LAS float* red = (LAS float*)(lds + 20480);
            for (int e = tid; e < 5 * D; e += 512) { const int r = e >> 10, k = e & 1023; const float x = r == 0 ? p.c_ctx[k] : p.c[(r - 1) * D + k]; sc[e] = x / (1.0f + expf(-x)); }
            __syncthreads();
            for (int it = bid; it < 144; it += G) {
                float a0 = 0.f, a1 = 0.f, a2 = 0.f, a3 = 0.f, a4 = 0.f; const float* wp = p.w_ada + (size_t)(wave * 128) * (NMOD * D) + it * 64 + lane;
#pragma unroll 16
                for (int k = 0; k < 128; ++k) { const float w = __builtin_nontemporal_load(wp + (size_t)k * (NMOD * D)); const int kk = wave * 128 + k;
                    a0 += sc[kk] * w; a1 += sc[1024 + kk] * w; a2 += sc[2048 + kk] * w; a3 += sc[3072 + kk] * w; a4 += sc[4096 + kk] * w; }
                red[(wave * 5 + 0) * 64 + lane] = a0; red[(wave * 5 + 1) * 64 + lane] = a1; red[(wave * 5 + 2) * 64 + lane] = a2; red[(wave * 5 + 3) * 64 + lane] = a3; red[(wave * 5 + 4) * 64 + lane] = a4;
                __syncthreads();
                if (tid < 320) { const int r = tid >> 6, l = tid & 63; float s = p.b_ada[it * 64 + l];
#pragma unroll
                    for (int w = 0; w < 8; ++w) s += red[(w * 5 + r) * 64 + l];
                    ((float*)(ws + WS_MOD))[(size_t)r * (NMOD * D) + it * 64 + l] = s; }
                __syncthreads();
            }
        }
        __syncthreads();
        {
            const bool spare = G > 176; const int cgw = spare ? (bid - 144) * 8 + wave : gw, cng = spare ? (G - 144) * 8 : NGW;
            if (!spare || bid >= 144) {
                conv_matrix<1>(p.w_ffn1_in, D, 2 * FF, (bf16_t*)(ws + WS_W1), scr, cgw, cng, lane);
                conv_matrix<0>(p.w_ffn1_out, FF, D, (bf16_t*)(ws + WS_W2), scr, cgw, cng, lane); } }
        if (gt < 8) ((float*)(ws + WS_LG))[gt] = lg2_decay_slow(p.decay, gt);
        for (int e = gt; e < 1024 * 64; e += NGT) {
            const int pos = e >> 6, pp = e & 63; const float freq = exp2f(-(float)(pp & 31) * (13.287712379549449f / 32.0f));
            const float ang = (float)(pp < 32 ? (pos >> 6) : (pos & 63)) * freq; float rev = ang * 0.15915494309189535f; rev -= floorf(rev);
            ((f32x2*)(ws + WS_ROPE))[e] = (f32x2){__builtin_amdgcn_cosf(rev), __builtin_amdgcn_sinf(rev)};
        }
        for (int e = gt; e < 4 * 256 * 256 / 2; e += NGT) {
            const int g = e >> 15, r = (e >> 7) & 255, c2 = (e & 127) * 2; float v0 = 0.f, v1 = 0.f;
            if ((r >> 7) == (c2 >> 7)) { const float* wp = p.w_sp + ((size_t)g * 128 + (r & 127)) * 128 + (c2 & 127); v0 = wp[0]; v1 = wp[1]; }
            ((unsigned*)(ws + WS_BD))[e] = cvt_pk_bf16(v0, v1);
        }
    }
    SEAM(0);
    if (IN(1)) { LOADP;
        norm_pass<false, true>(p, nullptr, nullptr, 0.f, 0, 0, (bf16_t*)(ws + WS_H), 0, 0, 1, gw, NGW, lane); }
    SEAM(1);
    if (IN(2)) { LOADP;  SchedSwiglu S{(const char*)(ws + WS_H), (const char*)(ws + WS_W1), G, bid}; Epi<2> E{p, xl}; gemm_phase<Epi<2>, SchedSwiglu, false, true>(lds, S, E);
        {
            const bool spare = (G == 256); const int cgw = spare ? (bid - 64) * 8 + wave : gw, cng = spare ? (G - 64) * 8 : NGW;
            if (!spare || bid >= 64) { __syncthreads();
                conv_matrix<2>(p.w_in, D, 7168, (bf16_t*)(ws + WS_WIN), scr, cgw, cng, lane);
                conv_wkv(p.w_in, (bf16_t*)((unsigned char*)p.out + OUT_WKV), scr, cgw, cng, lane);
                conv_matrix<0>(p.w_ret_br, D, D, (bf16_t*)(ws + WS_WR), scr, cgw, cng, lane);
                conv_matrix<0>(p.w_sg_br, D, D, (bf16_t*)(ws + WS_WS), scr, cgw, cng, lane);
                conv_matrix<0>(p.w_out, D, D, (bf16_t*)(ws + WS_WO), scr, cgw, cng, lane); } } }
    SEAM(2);
    if (IN(3)) { LOADP;  SchedT192 S{(const char*)(ws + WS_ACT), (const char*)(ws + WS_W2), FF * 2, FF * 2, 44, G, bid}; Epi<3> E{p, xl}; gemm_phase<Epi<3>, SchedT192, true>(lds, S, E); }
    SEAM(3);
    if (IN(5)) { LOADP;  SchedIn S{(const char*)p.out + OUT_H2, (const char*)(ws + WS_WIN), G, bid}; Epi<5> E{p, xl}; gemm_phase(lds, S, E); }
    SEAM(5);
    if (IN(6)) { LOADP;
        { SchedScores S{(const char*)(ws + WS_Q), (const char*)(ws + WS_K), (const char*)p.out + OUT_H2, (const char*)p.out + OUT_WKV - (size_t)512 * 2048, G, bid}; Epi<6> E{p, xl}; gemm_phase(lds, S, E); }
        __syncthreads();
#ifndef NO_P6_PASSES
        {
            bf16_t* gvt = (bf16_t*)(ws + WS_GVT); LAS float* red = (LAS float*)lds;
            const int rsub = tid >> 3, c8 = tid & 7;
            for (int it = (G == 256 ? (bid < 192 ? bid : M / 64) : bid); it < M / 64; it += G) {
                const int t0 = it * 64 + 8 * c8; float s[8], q[8];
#pragma unroll
                for (int j = 0; j < 8; ++j) { s[j] = 0.f; q[j] = 0.f; }
#pragma unroll 4
                for (int sw = 0; sw < 16; ++sw) { const int ch = sw * 64 + rsub; f32x4 a, b; unpack8(*(const u32x4*)(gvt + (size_t)ch * LD_GVT + t0), a, b);
#pragma unroll
                    for (int j = 0; j < 4; ++j) { s[j] += a[j]; q[j] += a[j] * a[j]; s[4 + j] += b[j]; q[4 + j] += b[j] * b[j]; } }
#pragma unroll
                for (int j = 0; j < 8; ++j) { s[j] += __shfl_xor(s[j], 8); s[j] += __shfl_xor(s[j], 16); s[j] += __shfl_xor(s[j], 32); q[j] += __shfl_xor(q[j], 8); q[j] += __shfl_xor(q[j], 16); q[j] += __shfl_xor(q[j], 32); }
                if (lane < 8) {
#pragma unroll
                    for (int j = 0; j < 8; ++j) { red[(wave * 64 + 8 * c8 + j) * 2 + 0] = s[j]; red[(wave * 64 + 8 * c8 + j) * 2 + 1] = q[j]; } }
                __syncthreads();
                float mean[8], rstd[8];
#pragma unroll
                for (int j = 0; j < 8; ++j) { float ss = 0.f, qq = 0.f;
#pragma unroll
                    for (int w = 0; w < 8; ++w) { ss += red[(w * 64 + 8 * c8 + j) * 2 + 0]; qq += red[(w * 64 + 8 * c8 + j) * 2 + 1]; }
                    mean[j] = ss * (1.f / D); float var = qq * (1.f / D) - mean[j] * mean[j]; var = var > 0.f ? var : 0.f; rstd[j] = 1.0f / sqrtf(var + EPS); }
#pragma unroll 4
                for (int sw = 0; sw < 16; ++sw) { const int ch = sw * 64 + rsub; bf16_t* ptr = gvt + (size_t)ch * LD_GVT + t0; f32x4 a, b; unpack8(*(const u32x4*)ptr, a, b);
                    const float gs = p.g_sg[ch], bs = p.b_sg[ch];
#pragma unroll
                    for (int j = 0; j < 4; ++j) { a[j] = (a[j] - mean[j]) * rstd[j] * gs + bs; b[j] = (b[j] - mean[4 + j]) * rstd[4 + j] * gs + bs; }
                    *(u32x4*)ptr = pack8(a, b); }
                __syncthreads();
            }
        }
        {
            const bf16_t* qb = (const bf16_t*)(ws + WS_Q); bf16_t* ps = (bf16_t*)(ws + WS_PS); const float* lgt = (const float*)(ws + WS_LG);
            for (int e = gt; e < MS * 4 * 16; e += NGT) { const int dc = e & 15, h = (e >> 4) & 3, tok = e >> 6, b = tok >> 10, pos = tok & 1023;
                f32x4 q0, q1; unpack8(*(const u32x4*)(qb + (size_t)(MP + tok) * 512 + h * 128 + dc * 8), q0, q1);
                const float ff = exp2f(lgt[h] * (float)(pos + 1)), fb = exp2f(lgt[4 + h] * (float)(1024 - pos));
                bf16_t* dst = ps + ((size_t)((b * 4 + h) * 1024 + pos)) * 1280 + 1024 + dc * 8;
                *(u32x4*)dst = pack8(q0 * ff, q1 * ff); *(u32x4*)(dst + 128) = pack8(q0 * fb, q1 * fb); }
        }
        {
            bf16_t* vts = (bf16_t*)(ws + WS_VTS);
            for (int e = gt; e < 32 * 256 * 16; e += NGT) { const int ee = e & 255, dc = (e >> 8) & 15, bhd = e >> 12, dir = bhd & 1, bh = bhd >> 1;
                const float* src = (dir ? p.s0b : p.s0f) + ((size_t)bh * 128 + dc * 8) * 256 + ee;
                u32x4 o; o.x = cvt_pk_bf16(src[0], src[256]); o.y = cvt_pk_bf16(src[512], src[768]); o.z = cvt_pk_bf16(src[1024], src[1280]); o.w = cvt_pk_bf16(src[1536], src[1792]);
                *(u32x4*)(vts + ((size_t)((bh >> 2) * 1024 + (bh & 3) * 256 + ee)) * 1280 + 1024 + dir * 128 + dc * 8) = o; }
        }
#endif
    }
    SEAM(6);
    if (IN(7)) { LOADP;  SchedMix S{ws, G, bid}; Epi<7> E{p, xl}; gemm_phase(lds, S, E); }
    SEAM(7);
    if (IN(8)) { LOADP;
        {   const bool spare = G > 192; const int cgw = spare ? (bid - 192) * 8 + wave : gw, cng = spare ? (G - 192) * 8 : NGW;
            if (!spare || bid >= 192) {
                conv_matrix<1>(p.w_ffn2_in, D, 2 * FF, (bf16_t*)(ws + WS_W3), scr, cgw, cng, lane);
                conv_matrix<0>(p.w_ffn2_out, FF, D, (bf16_t*)(ws + WS_W4), scr, cgw, cng, lane);
                __syncthreads(); } }
        SchedMerge S{ws, G, bid}; Epi<8> E{p, xl}; gemm_phase(lds, S, E);
    }
    SEAM(8);
    if (IN(9)) { LOADP;  SchedT192 S{(const char*)(ws + WS_MERGED), (const char*)(ws + WS_WO), 2048, 2048, 16, G, bid}; Epi<9> E{p, xl}; gemm_phase<Epi<9>, SchedT192, true>(lds, S, E); }
    SEAM(9);
    if (IN(11)) { LOADP;  SchedSwiglu S{(const char*)(ws + WS_H3), (const char*)(ws + WS_W3), G, bid}; Epi<2> E{p, xl}; gemm_phase<Epi<2>, SchedSwiglu, false, true>(lds, S, E); }
    SEAM(11);
    if (IN(12)) { LOADP;  SchedT192 S{(const char*)(ws + WS_ACT), (const char*)(ws + WS_W4), FF * 2, FF * 2, 44, G, bid}; Epi<12> E{p, xl}; gemm_phase<Epi<12>, SchedT192, true>(lds, S, E); }
#undef IN
#undef SEAM
}

#ifndef RUN_MASK
#define RUN_MASK 0x3fff
#endif
#ifndef MK_N_LAUNCHES
#define MK_N_LAUNCHES 1
#endif
extern "C" void kernel_launch(void* const* d_in, const int* in_sizes, int n_in, void* d_out, int out_size, void* d_ws, size_t ws_size, hipStream_t stream) {
    static int grid = 0;
    if (grid == 0) {
        if (n_in != 23 || ws_size < WS_END) { fprintf(stderr, "kernel_launch: unexpected inputs (n_in %d, ws %zu)\n", n_in, ws_size); grid = -1; return; }
        int dev = 0, cus = 0, per_cu = 0;
        if (hipGetDevice(&dev) != hipSuccess || hipDeviceGetAttribute(&cus, hipDeviceAttributeMultiprocessorCount, dev) != hipSuccess) { grid = -1; return; }
        if (hipFuncSetAttribute((const void*)fwd_kernel, hipFuncAttributeMaxDynamicSharedMemorySize, LDS_BYTES) != hipSuccess) { fprintf(stderr, "kernel_launch: hipFuncSetAttribute failed\n"); grid = -1; return; }
        if (hipOccupancyMaxActiveBlocksPerMultiprocessor(&per_cu, (const void*)fwd_kernel, 512, LDS_BYTES) != hipSuccess || per_cu < 1) { fprintf(stderr, "kernel_launch: occupancy query says %d\n", per_cu); per_cu = 1; }
        (void)hipGetLastError();
        grid = cus;
    }
    if (grid < 0) return;
    Params p{};
    p.x_prompt = (const float*)d_in[0]; p.x_sample = (const float*)d_in[1]; p.s0f = (const float*)d_in[2]; p.s0b = (const float*)d_in[3]; p.c = (const float*)d_in[4]; p.c_ctx = (const float*)d_in[5];
    p.w_ada = (const float*)d_in[6]; p.b_ada = (const float*)d_in[7]; p.g_norm = (const float*)d_in[8]; p.w_ffn1_in = (const float*)d_in[9]; p.w_ffn1_out = (const float*)d_in[10]; p.w_in = (const float*)d_in[11];
    p.decay = (const float*)d_in[12]; p.g_ret = (const float*)d_in[13]; p.w_ret_br = (const float*)d_in[14]; p.g_sg = (const float*)d_in[15]; p.b_sg = (const float*)d_in[16]; p.w_sp = (const float*)d_in[17]; p.b_sp = (const float*)d_in[18];
    p.w_sg_br = (const float*)d_in[19]; p.w_out = (const float*)d_in[20]; p.w_ffn2_in = (const float*)d_in[21]; p.w_ffn2_out = (const float*)d_in[22];
    p.out = (float*)d_out; p.ws = (unsigned char*)d_ws;
#if MK_N_LAUNCHES == 1
    (void)hipMemsetAsync((char*)d_ws + WS_BAR, 0, 65536, stream);
    p.ph_lo = RUN_MASK; p.ph_hi = 1;
    void* args[] = {&p};
    hipError_t e = hipLaunchCooperativeKernel((const void*)fwd_kernel, dim3(grid), dim3(512), args, LDS_BYTES, stream);
    if (e != hipSuccess) fprintf(stderr, "kernel_launch: cooperative launch failed: %s (grid %d)\n", hipGetErrorString(e), grid);
#else
    for (int ph = 0; ph < 14; ++ph) { p.ph_lo = 1 << ph; p.ph_hi = 0; hipLaunchKernelGGL(fwd_kernel, dim3(grid), dim3(512), LDS_BYTES, stream, p); }
#endif
}
```

```cpp
#include <hip/hip_runtime.h>
#include <hip/hip_cooperative_groups.h>
#include <cstdio>
#include <cstdint>
namespace cg = cooperative_groups;

#define LAS __attribute__((address_space(3)))
typedef unsigned short bf16_t;
typedef short bf16x8 __attribute__((ext_vector_type(8)));
typedef float f32x4 __attribute__((ext_vector_type(4)));
typedef float f32x2 __attribute__((ext_vector_type(2)));
typedef unsigned u32x4 __attribute__((ext_vector_type(4)));
typedef unsigned u32x2 __attribute__((ext_vector_type(2)));

constexpr int D = 1024, MP = 8192, MS = 4096, M = 12288, FF = 2816, NMOD = 9;
constexpr float EPS = 1e-6f;
constexpr size_t MiB = 1u << 20, KiB = 1u << 10;
constexpr size_t WS_WR = 0, WS_WS = 2 * MiB, WS_WO = 4 * MiB, WS_BD = 6 * MiB, WS_MOD = 6 * MiB + 512 * KiB, WS_ROPE = 7 * MiB, WS_LG = 6 * MiB + 768 * KiB, WS_BAR = 6 * MiB + 832 * KiB, WS_CNT = WS_BAR + 16 * KiB, WS_XS = 7 * MiB + 512 * KiB;
constexpr size_t WS_W1 = 8 * MiB, WS_W2 = 19 * MiB, WS_WIN = 24 * MiB + 512 * KiB, WS_H = 38 * MiB + 512 * KiB;
constexpr size_t WS_PP = 8 * MiB, WS_PS = 24 * MiB;
constexpr size_t WS_W3 = 8 * MiB, WS_W4 = 19 * MiB, WS_H3 = 24 * MiB + 512 * KiB;
constexpr int LD_VTP = MP + 64, LD_KT = MP + 64, LD_GVT = M + 64;
constexpr size_t WS_Q = 64 * MiB, WS_K = 76 * MiB, WS_VTP = 88 * MiB, WS_VTS = 105 * MiB, WS_KT = 115 * MiB, WS_G = 132 * MiB, WS_U = 156 * MiB,
                 WS_GVT = 180 * MiB, WS_GATES = 205 * MiB;
constexpr size_t WS_ACT = 64 * MiB, WS_F = 130 * MiB, WS_TMP = 64 * MiB, WS_MERGED = 180 * MiB, WS_Y = 132 * MiB, WS_END = 253 * MiB;
static_assert((size_t)1024 * LD_VTP * 2 <= 17 * MiB && (size_t)1024 * LD_GVT * 2 <= 25 * MiB, "padded buffers fit");
constexpr size_t OUT_H2 = (size_t)M * D * 4, OUT_WKV = OUT_H2 + 24 * MiB;
constexpr int LDS_BYTES = 147456, XL_OFF = 131072, MISC_OFF = 131072 + 8192;

struct Params {
    const float* x_prompt; const float* x_sample; const float* s0f; const float* s0b; const float* c; const float* c_ctx;
    const float* w_ada; const float* b_ada; const float* g_norm; const float* w_ffn1_in; const float* w_ffn1_out; const float* w_in;
    const float* decay; const float* g_ret; const float* w_ret_br; const float* g_sg; const float* b_sg; const float* w_sp; const float* b_sp;
    const float* w_sg_br; const float* w_out; const float* w_ffn2_in; const float* w_ffn2_out;
    float* out; unsigned char* ws; int ph_lo, ph_hi;
};

typedef __bf16 bf16x2_t __attribute__((ext_vector_type(2)));
__device__ __forceinline__ unsigned cvt_pk_bf16(float lo, float hi) { const f32x2 v = {lo, hi}; const bf16x2_t b = __builtin_convertvector(v, bf16x2_t); return __builtin_bit_cast(unsigned, b); }
__device__ __forceinline__ u32x4 pack8(f32x4 a, f32x4 b) { u32x4 w; w.x = cvt_pk_bf16(a[0], a[1]); w.y = cvt_pk_bf16(a[2], a[3]); w.z = cvt_pk_bf16(b[0], b[1]); w.w = cvt_pk_bf16(b[2], b[3]); return w; }
__device__ __forceinline__ void unpack8(u32x4 w, f32x4& a, f32x4& b) {
    a[0] = __uint_as_float(w.x << 16); a[1] = __uint_as_float(w.x & 0xffff0000u); a[2] = __uint_as_float(w.y << 16); a[3] = __uint_as_float(w.y & 0xffff0000u);
    b[0] = __uint_as_float(w.z << 16); b[1] = __uint_as_float(w.z & 0xffff0000u); b[2] = __uint_as_float(w.w << 16); b[3] = __uint_as_float(w.w & 0xffff0000u);
}
__device__ __forceinline__ float fsigmoid(float x) { return __builtin_amdgcn_rcpf(1.f + __builtin_amdgcn_exp2f(-1.44269504f * x)); }
__device__ __forceinline__ float fsilu(float x) { return x * fsigmoid(x); }
__device__ __forceinline__ float fgelu(float x) { const float z = 0.7978845608f * (x + 0.044715f * x * x * x); return x * fsigmoid(2.f * z); }
__device__ __forceinline__ f32x4 silu4(f32x4 v) { return (f32x4){fsilu(v[0]), fsilu(v[1]), fsilu(v[2]), fsilu(v[3])}; }
__device__ __forceinline__ f32x4 gelu4(f32x4 v) { return (f32x4){fgelu(v[0]), fgelu(v[1]), fgelu(v[2]), fgelu(v[3])}; }
__device__ __forceinline__ f32x4 sigm4(f32x4 v) { return (f32x4){fsigmoid(v[0]), fsigmoid(v[1]), fsigmoid(v[2]), fsigmoid(v[3])}; }
__device__ __forceinline__ float wave_sum(float v) {
#pragma unroll
    for (int o = 1; o < 64; o <<= 1) v += __shfl_xor(v, o);
    return v;
}
__device__ __forceinline__ float lg2_decay_slow(const float* decay, int i) { const float x = decay[i]; return -log1pf(expf(-x)) * 1.44269504f; }
__device__ __forceinline__ float lg2_decay(const float* lgt, int dir, int h) { return lgt[dir * 4 + h]; }
#define LDS_WAIT() asm volatile("s_waitcnt lgkmcnt(0)" ::: "memory")
#define WG_BAR() do { asm volatile("s_waitcnt lgkmcnt(0)" ::: "memory"); __builtin_amdgcn_s_barrier(); asm volatile("" ::: "memory"); } while (0)

constexpr int HTB = 128 * 64 * 2;
__device__ __forceinline__ int lds_byte(int r, int c) { const int st = (r >> 4) * 2 + (c >> 5), rr = r & 15, cc = c & 31, ob = rr * 64 + cc * 2; return st * 1024 + (ob ^ (((ob >> 9) & 1) << 5)); }
__device__ __forceinline__ void stage_rc(int b, int& R, int& C) { const int st = b / 1024, sb = b % 1024, swz = sb ^ (((sb >> 9) & 1) << 5); R = (st >> 1) * 16 + swz / 64; C = (st & 1) * 32 + (swz % 64) / 2; }
__device__ __forceinline__ int perm32(int rho) { const int n = rho >> 4, i = rho & 15; return 8 * (i >> 2) + 4 * n + (i & 3); }

struct Unit { const char* a; const char* b; unsigned lda, ldb; int nt, kind, pm, pn, aux; };

__device__ __forceinline__ void tile_map(int idx, int nM, int nN, int& pm, int& pn) {
    const int nwg = nM * nN; int wgid = idx;
    { const int q = nwg / 8, r = nwg % 8, xcd = wgid % 8, off = wgid / 8; wgid = (xcd < r ? xcd * (q + 1) : r * (q + 1) + (xcd - r) * q) + off; }
    const int nig = 8 * nN, gid = wgid / nig, fm = gid * 8, gsz = (nM - fm) < 8 ? (nM - fm) : 8;
    pm = fm + ((wgid % nig) % gsz); pn = (wgid % nig) / gsz;
}

#define EPI_ARGS const f32x4 (&acc)[2][2][4][2], const Unit& u, int wr, int wc, int fr, int fq

constexpr int UNIT_HALF_KIND = 17;
template <class Epi, class Sched, bool HM2 = false, bool HC = false>
__device__ __forceinline__ void gemm_phase(LAS unsigned char* lds, const Sched& S, const Epi& E) {
    const int tid = threadIdx.x, wid = __builtin_amdgcn_readfirstlane(tid >> 6), lane = tid & 63, wr = wid >> 2, wc = wid & 3, fr = lane & 15, fq = lane >> 4;
    int RA, RB, C2;
    { int R, C; stage_rc(tid * 16, R, C); RA = R; RB = (R & ~31) + perm32(R & 31); C2 = C * 2; }
    const unsigned ldsw = (unsigned)wid * 1024u;
    const int aoff = lds_byte(wr * 64 + fr, fq * 8), boff = lds_byte(wc * 32 + fr, fq * 8);
#define PG8_SA(b, h) (((b) * 2 + (h)) * HTB)
#define PG8_SB(b, h) ((4 + (b) * 2 + (h)) * HTB)
#define PG8_STAGE(bufoff, gbase, RR, ld) do { const unsigned _vo = (unsigned)(RR * (int)(ld) + C2); _Pragma("unroll") for (int _i = 0; _i < 2; ++_i) { \
        const char* _gb = (const char*)(gbase) + (size_t)(_i * 64u * (ld)); asm volatile("" : "+s"(_gb)); \
        __builtin_amdgcn_global_load_lds((const unsigned*)(_gb + _vo), (LAS unsigned*)(lds + (bufoff) + ldsw + _i * 8192), 16, 0, 0); } } while (0)
#define PG8_STAGE_A1(bufoff, gbase, ld) do { if (HM2) { const unsigned _vo = (unsigned)((RA & 31) * (int)(ld) + C2); _Pragma("unroll") for (int _i = 0; _i < 2; ++_i) { \
        const char* _gb = (const char*)(gbase) + (size_t)(_i * 32u * (ld)); asm volatile("" : "+s"(_gb)); \
        __builtin_amdgcn_global_load_lds((const unsigned*)(_gb + _vo), (LAS unsigned*)(lds + (bufoff) + ldsw + _i * 8192), 16, 0, 0); } } else PG8_STAGE(bufoff, gbase, RA, ld); } while (0)
#define PG8_LDA1(dst, b) do { _Pragma("unroll") for (int m = 0; m < (HM2 ? 2 : 4); ++m) _Pragma("unroll") for (int k = 0; k < 2; ++k) dst[m][k] = *(const LAS bf16x8*)(lds + PG8_SA(b, 1) + aoff + m * 2048 + k * 1024); } while (0)
#define PG8_MMA1(bj, At, Bt) do { __builtin_amdgcn_s_setprio(1); _Pragma("unroll") for (int m = 0; m < (HM2 ? 2 : 4); ++m) _Pragma("unroll") for (int n = 0; n < 2; ++n) _Pragma("unroll") for (int k = 0; k < 2; ++k) \
        acc[1][bj][m][n] = __builtin_amdgcn_mfma_f32_16x16x32_bf16(Bt[n][k], At[m][k], acc[1][bj][m][n], 0, 0, 0); __builtin_amdgcn_s_setprio(0); } while (0)
#define PG8_LDA(dst, b, h) do { _Pragma("unroll") for (int m = 0; m < 4; ++m) _Pragma("unroll") for (int k = 0; k < 2; ++k) dst[m][k] = *(const LAS bf16x8*)(lds + PG8_SA(b, h) + aoff + m * 2048 + k * 1024); } while (0)
#define PG8_LDB(dst, b, h) do { _Pragma("unroll") for (int n = 0; n < 2; ++n) _Pragma("unroll") for (int k = 0; k < 2; ++k) dst[n][k] = *(const LAS bf16x8*)(lds + PG8_SB(b, h) + boff + n * 2048 + k * 1024); } while (0)
#define PG8_MMA(ai, bj, At, Bt) do { __builtin_amdgcn_s_setprio(1); _Pragma("unroll") for (int m = 0; m < 4; ++m) _Pragma("unroll") for (int n = 0; n < 2; ++n) _Pragma("unroll") for (int k = 0; k < 2; ++k) \
        acc[ai][bj][m][n] = __builtin_amdgcn_mfma_f32_16x16x32_bf16(Bt[n][k], At[m][k], acc[ai][bj][m][n], 0, 0, 0); __builtin_amdgcn_s_setprio(0); } while (0)
#define PG8_WAIT_V(n) asm volatile("s_waitcnt vmcnt(" #n ")" ::: "memory")
#define PG8_WAIT_L(n) asm volatile("s_waitcnt lgkmcnt(" #n ")" ::: "memory")
#define PG8_BAR __builtin_amdgcn_s_barrier()
#define PG8_SCHED __builtin_amdgcn_sched_barrier(0)
    Unit cur, nxt; int ui = 0;
    if (!S.next(0, cur)) return;
    f32x4 acc[2][2][4][2];
#pragma unroll
    for (int a = 0; a < 2; ++a)
#pragma unroll
        for (int b = 0; b < 2; ++b)
#pragma unroll
            for (int m = 0; m < 4; ++m)
#pragma unroll
                for (int n = 0; n < 2; ++n) acc[a][b][m][n] = (f32x4){0.f, 0.f, 0.f, 0.f};
    bf16x8 At[4][2], B0[2][2], B1[2][2];
    const char* cA = cur.a; const char* cB = cur.b; unsigned cla = cur.lda, clb = cur.ldb;
    PG8_STAGE(PG8_SB(0, 0), cB, RB, clb); PG8_STAGE(PG8_SB(0, 1), cB + 128u * clb, RB, clb); PG8_STAGE(PG8_SA(0, 0), cA, RA, cla); PG8_STAGE_A1(PG8_SA(0, 1), cA + 128u * cla, cla);
    if (wr == 1) PG8_BAR;
    PG8_WAIT_V(2); PG8_BAR;
    PG8_STAGE(PG8_SB(1, 0), cB + 128, RB, clb); PG8_STAGE(PG8_SA(1, 0), cA + 128, RA, cla); PG8_STAGE(PG8_SB(1, 1), cB + 128u * clb + 128, RB, clb);
    PG8_WAIT_V(6); PG8_BAR;
    for (;;) {
        const bool has_next = S.next(ui + 1, nxt);
        const char* nA = has_next ? nxt.a : cA; const char* nB = has_next ? nxt.b : cB;
        const unsigned nla = has_next ? nxt.lda : cla, nlb = has_next ? nxt.ldb : clb;
        const int nt = cur.nt; const bool halfu = HC && cur.kind == UNIT_HALF_KIND;
        for (int t = 0; t < nt; t += 2) {
            const bool last = (t == nt - 2);
            const char* a1 = cA + (size_t)(t + 1) * 128;
            const char* a2 = last ? nA : cA + (size_t)(t + 2) * 128; const char* b2 = last ? nB : cB + (size_t)(t + 2) * 128;
            const unsigned la2 = last ? nla : cla, lb2 = last ? nlb : clb;
            const char* a3 = a2 + 128; const char* b3 = b2 + 128;
            PG8_LDB(B0, 0, 0); PG8_LDB(B1, 0, 1); PG8_SCHED; PG8_LDA(At, 0, 0); PG8_STAGE_A1(PG8_SA(1, 1), a1 + 128u * cla, cla);
            PG8_WAIT_V(8); PG8_WAIT_L(0); PG8_BAR; PG8_MMA(0, 0, At, B0); PG8_MMA(0, 1, At, B1); PG8_BAR; PG8_SCHED;
            if (!halfu) PG8_LDA1(At, 0); PG8_STAGE(PG8_SB(0, 0), b2, RB, lb2); PG8_STAGE(PG8_SB(0, 1), b2 + 128u * lb2, RB, lb2); PG8_STAGE(PG8_SA(0, 0), a2, RA, la2);
            PG8_WAIT_V(8); PG8_WAIT_L(0); PG8_BAR; if (!halfu) { PG8_MMA1(0, At, B0); PG8_MMA1(1, At, B1); } PG8_BAR; PG8_SCHED;
            PG8_LDB(B0, 1, 0); PG8_LDB(B1, 1, 1); PG8_SCHED; PG8_LDA(At, 1, 0); PG8_STAGE_A1(PG8_SA(0, 1), a2 + 128u * la2, la2);
            PG8_WAIT_V(8); PG8_WAIT_L(0); PG8_BAR; PG8_MMA(0, 0, At, B0); PG8_MMA(0, 1, At, B1); PG8_BAR; PG8_SCHED;
            if (!halfu) PG8_LDA1(At, 1); PG8_STAGE(PG8_SB(1, 0), b3, RB, lb2); PG8_STAGE(PG8_SB(1, 1), b3 + 128u * lb2, RB, lb2); PG8_STAGE(PG8_SA(1, 0), a3, RA, la2);
            PG8_WAIT_V(8); PG8_WAIT_L(0); PG8_BAR; if (!halfu) { PG8_MMA1(0, At, B0); PG8_MMA1(1, At, B1); } PG8_BAR; PG8_SCHED;
        }
        if (wr == 0) PG8_BAR;
        E(acc, cur, wr, wc, fr, fq);
        if (!has_next) break;
#pragma unroll
        for (int a = 0; a < 2; ++a)
#pragma unroll
            for (int b = 0; b < 2; ++b)
#pragma unroll
                for (int m = 0; m < 4; ++m)
#pragma unroll
                    for (int n = 0; n < 2; ++n) acc[a][b][m][n] = (f32x4){0.f, 0.f, 0.f, 0.f};
        cur = nxt; cA = nA; cB = nB; cla = nla; clb = nlb; ++ui;
        if (wr == 1) PG8_BAR;
    }
    PG8_WAIT_V(0);
    PG8_BAR;
#undef PG8_SA
#undef PG8_SB
#undef PG8_STAGE
#undef PG8_LDA
#undef PG8_LDA1
#undef PG8_MMA1
#undef PG8_STAGE_A1
#undef PG8_LDB
#undef PG8_MMA
#undef PG8_WAIT_V
#undef PG8_WAIT_L
#undef PG8_BAR
#undef PG8_SCHED
}

enum Kind { K_SWIGLU = 0, K_F32, K_QK, K_G, K_U, K_GATES, K_VT, K_GVT, K_KT, K_SC_P, K_SC_S, K_PV_P, K_PV_S, K_STATE, K_SPATIAL, K_MERGE0, K_MERGE1, K_SWIGLU_H   };
static_assert(K_SWIGLU_H == UNIT_HALF_KIND, "kind id used by the engine");

__device__ __forceinline__ void epi_swiglu(EPI_ARGS, bf16_t* out) {
    const bool halfu = u.kind == K_SWIGLU_H;
    const int row0 = u.pm * 256 + (halfu ? u.aux : 0) + wr * 64 + fr, col0 = u.pn * 128 + wc * 32 + 8 * fq;
#pragma unroll
    for (int ai = 0; ai < 2; ++ai)
#pragma unroll
        for (int m = 0; m < 4; ++m) { if (ai == 1 && halfu) continue;
            const f32x4 o0 = silu4(acc[ai][0][m][0]) * acc[ai][1][m][0], o1 = silu4(acc[ai][0][m][1]) * acc[ai][1][m][1];
            *(u32x4*)(out + (size_t)(row0 + ai * 128 + m * 16) * FF + col0) = pack8(o0, o1);
        }
}
__device__ __forceinline__ void epi_f32(EPI_ARGS, bf16_t* out, int ld) {
    const int row0 = u.pm * 256 + wr * 64 + fr, col0 = u.pn * 256 + wc * 32 + 8 * fq;
#pragma unroll
    for (int ai = 0; ai < 2; ++ai)
#pragma unroll
        for (int m = 0; m < 4; ++m) { bf16_t* rp = out + (size_t)(row0 + ai * 128 + m * 16) * ld + col0;
#pragma unroll
            for (int bj = 0; bj < 2; ++bj) *(u32x4*)(rp + bj * 128) = pack8(acc[ai][bj][m][0], acc[ai][bj][m][1]); }
}
template <int ACT> __device__ __forceinline__ void epi_act(EPI_ARGS, bf16_t* out, int ld, int colbase) {
    const int row0 = u.pm * 256 + wr * 64 + fr, col0 = colbase + wc * 32 + 8 * fq;
#pragma unroll
    for (int ai = 0; ai < 2; ++ai)
#pragma unroll
        for (int m = 0; m < 4; ++m) { bf16_t* rp = out + (size_t)(row0 + ai * 128 + m * 16) * ld + col0;
#pragma unroll
            for (int bj = 0; bj < 2; ++bj) { f32x4 v0 = acc[ai][bj][m][0], v1 = acc[ai][bj][m][1];
                if (ACT == 0) { v0 = silu4(v0); v1 = silu4(v1); } else if (ACT == 1) { v0 = gelu4(v0); v1 = gelu4(v1); } else { v0 = sigm4(v0); v1 = sigm4(v1); }
                *(u32x4*)(rp + bj * 128) = pack8(v0, v1); } }
}
__device__ __forceinline__ void epi_qk(EPI_ARGS, bf16_t* dst, float scale, const float* rope) {
    const int hp = u.aux, o0 = wc * 32 + 8 * fq, head = hp * 2 + (o0 >> 6), p0 = o0 & 63;
    const bool do_rope = u.pm >= 32;
#pragma unroll
    for (int ai = 0; ai < 2; ++ai) {
        f32x4 cs[4][4];
        if (do_rope) {
#pragma unroll
            for (int m = 0; m < 4; ++m) { const int pos = (u.pm * 256 + ai * 128 + wr * 64 + m * 16 + fr - MP) & 1023; const f32x4* cp = (const f32x4*)(rope + ((size_t)pos * 64 + p0) * 2);
                cs[m][0] = cp[0]; cs[m][1] = cp[1]; cs[m][2] = cp[2]; cs[m][3] = cp[3]; } }
#pragma unroll
        for (int m = 0; m < 4; ++m) {
            const int row = u.pm * 256 + ai * 128 + wr * 64 + m * 16 + fr;
            f32x4 x1a = acc[ai][0][m][0] * scale, x1b = acc[ai][0][m][1] * scale, x2a = acc[ai][1][m][0] * scale, x2b = acc[ai][1][m][1] * scale;
            if (do_rope) {
                const f32x4 c0 = cs[m][0], c1 = cs[m][1], c2 = cs[m][2], c3 = cs[m][3];
                const f32x4 ca = (f32x4){c0[0], c0[2], c1[0], c1[2]}, sa = (f32x4){c0[1], c0[3], c1[1], c1[3]};
                const f32x4 cb = (f32x4){c2[0], c2[2], c3[0], c3[2]}, sb = (f32x4){c2[1], c2[3], c3[1], c3[3]};
                const f32x4 y1a = x1a * ca - x2a * sa, y2a = x1a * sa + x2a * ca, y1b = x1b * cb - x2b * sb, y2b = x1b * sb + x2b * cb;
                x1a = y1a; x2a = y2a; x1b = y1b; x2b = y2b;
            }
            bf16_t* rp = dst + (size_t)row * 512 + head * 128 + p0;
            *(u32x4*)rp = pack8(x1a, x1b); *(u32x4*)(rp + 64) = pack8(x2a, x2b);
        }
    }
}
__device__ __forceinline__ void epi_vt(EPI_ARGS, bf16_t* vtp, bf16_t* vts) {
    const int wt = u.pm, tt = u.pn, c0 = wc * 32 + 8 * fq;
#pragma unroll
    for (int ai = 0; ai < 2; ++ai)
#pragma unroll
        for (int m = 0; m < 4; ++m) { const int vrow = wt * 256 + ai * 128 + wr * 64 + m * 16 + fr;
            bf16_t* rp;
            if (tt < 32) rp = vtp + (size_t)vrow * LD_VTP + tt * 256 + c0;
            else { const int b = (tt - 32) >> 2, pos0 = ((tt - 32) & 3) * 256 + c0; rp = vts + ((size_t)b * 1024 + vrow) * 1280 + pos0; }
#pragma unroll
            for (int bj = 0; bj < 2; ++bj) *(u32x4*)(rp + bj * 128) = pack8(acc[ai][bj][m][0], acc[ai][bj][m][1]); }
}
__device__ __forceinline__ void epi_gvt(EPI_ARGS, bf16_t* gvt) {
    const int wt = u.pm - 4, tt = u.pn, c0 = wc * 32 + 8 * fq;
#pragma unroll
    for (int ai = 0; ai < 2; ++ai)
#pragma unroll
        for (int m = 0; m < 4; ++m) { const int ch = wt * 256 + ai * 128 + wr * 64 + m * 16 + fr; bf16_t* rp = gvt + (size_t)ch * LD_GVT + tt * 256 + c0;
#pragma unroll
            for (int bj = 0; bj < 2; ++bj) *(u32x4*)(rp + bj * 128) = pack8(gelu4(acc[ai][bj][m][0]), gelu4(acc[ai][bj][m][1])); }
}
__device__ __forceinline__ void epi_kt(EPI_ARGS, bf16_t* kt, const float* decay) {
    const int hp = u.pm, tt = u.pn, head = hp * 2 + wr, c0 = wc * 32 + 8 * fq;
    const float lf = lg2_decay(decay, 0, head), lb = lg2_decay(decay, 1, head);
    f32x4 wf[2][2], wb[2][2];
#pragma unroll
    for (int bj = 0; bj < 2; ++bj)
#pragma unroll
        for (int n = 0; n < 2; ++n)
#pragma unroll
            for (int j = 0; j < 4; ++j) { const float t = (float)(bj * 128 + c0 + 4 * n + j); wf[bj][n][j] = __builtin_amdgcn_exp2f(lf * (255.f - t)); wb[bj][n][j] = __builtin_amdgcn_exp2f(lb * t); }
#pragma unroll
    for (int ai = 0; ai < 2; ++ai)
#pragma unroll
        for (int m = 0; m < 4; ++m) { const int dim = ai * 64 + m * 16 + fr;
            bf16_t* rf = kt + ((size_t)((head * 2 + 0) * 128 + dim)) * LD_KT + tt * 256 + c0; bf16_t* rb = rf + (size_t)128 * LD_KT;
#pragma unroll
            for (int bj = 0; bj < 2; ++bj) {
                *(u32x4*)(rf + bj * 128) = pack8(acc[ai][bj][m][0] * wf[bj][0], acc[ai][bj][m][1] * wf[bj][1]);
                *(u32x4*)(rb + bj * 128) = pack8(acc[ai][bj][m][0] * wb[bj][0], acc[ai][bj][m][1] * wb[bj][1]); } }
}
__device__ __forceinline__ void epi_scores(EPI_ARGS, bf16_t* pbase, int ldp, int q0, int k0, float lf, float lb) {
    const int c0 = wc * 32 + 8 * fq; const int d0 = q0 - k0; const float pf = d0 > 0 ? (float)d0 : 0.f, pb = d0 < 0 ? (float)(-d0) : 0.f;
#pragma unroll
    for (int bj = 0; bj < 2; ++bj) {
        f32x4 cf[2], cb[2]; const int cc = bj * 128 + c0;
#pragma unroll
        for (int n = 0; n < 2; ++n)
#pragma unroll
            for (int j = 0; j < 4; ++j) { const float ki = (float)(cc + 4 * n + j); cf[n][j] = __builtin_amdgcn_exp2f(-lf * ki); cb[n][j] = __builtin_amdgcn_exp2f(lb * (pb + ki)); }
#pragma unroll
        for (int ai = 0; ai < 2; ++ai)
#pragma unroll
            for (int m = 0; m < 4; ++m) { const int qi = ai * 128 + wr * 64 + m * 16 + fr;
                const float rf = __builtin_amdgcn_exp2f(lf * (pf + (float)qi)), rb = __builtin_amdgcn_exp2f(-lb * (float)qi); const int dq = d0 + qi - cc;
                f32x4 o[2];
#pragma unroll
                for (int n = 0; n < 2; ++n)
#pragma unroll
                    for (int j = 0; j < 4; ++j) { const int dlt = dq - (4 * n + j); const float w = dlt > 0 ? rf * cf[n][j] : (dlt < 0 ? rb * cb[n][j] : 2.0f); o[n][j] = acc[ai][bj][m][n][j] * w; }
                *(u32x4*)(pbase + (size_t)(q0 + qi) * ldp + k0 + cc) = pack8(o[0], o[1]);
                asm volatile("" ::: "memory"); }
    }
}
__device__ __forceinline__ void epi_pv(EPI_ARGS, LAS unsigned char* xl, bf16_t* gbuf, const float* g_ret, int tok0, int h) {
    LAS f32x2* P = (LAS f32x2*)xl;
#pragma unroll
    for (int ai = 0; ai < 2; ++ai)
#pragma unroll
        for (int m = 0; m < 4; ++m) { float s = 0.f, q = 0.f;
#pragma unroll
            for (int bj = 0; bj < 2; ++bj)
#pragma unroll
                for (int n = 0; n < 2; ++n) { const f32x4 x = acc[ai][bj][m][n]; s += (x[0] + x[1]) + (x[2] + x[3]); q += (x[0] * x[0] + x[1] * x[1]) + (x[2] * x[2] + x[3] * x[3]); }
            s += __shfl_xor(s, 16); s += __shfl_xor(s, 32); q += __shfl_xor(q, 16); q += __shfl_xor(q, 32);
            if (fq == 0) P[(ai * 128 + wr * 64 + m * 16 + fr) * 4 + wc] = (f32x2){s, q}; }
    WG_BAR();
    const int e0 = wc * 32 + 8 * fq;
    bf16_t* gp = gbuf + (size_t)(tok0 + wr * 64 + fr) * D + h * 256 + e0;
    f32x4 gr[2][2];
#pragma unroll
    for (int bj = 0; bj < 2; ++bj) { gr[bj][0] = *(const f32x4*)(g_ret + h * 256 + bj * 128 + e0); gr[bj][1] = *(const f32x4*)(g_ret + h * 256 + bj * 128 + e0 + 4); }
#pragma unroll
    for (int ai = 0; ai < 2; ++ai) {
        u32x4 gv[4][2];
#pragma unroll
        for (int m = 0; m < 4; ++m)
#pragma unroll
            for (int bj = 0; bj < 2; ++bj) gv[m][bj] = *(const u32x4*)(gp + (size_t)(ai * 128 + m * 16) * D + bj * 128);
#pragma unroll
        for (int m = 0; m < 4; ++m) { const int r = ai * 128 + wr * 64 + m * 16 + fr;
            const f32x2 pa = P[r * 4 + 0], pb = P[r * 4 + 1], pc = P[r * 4 + 2], pd = P[r * 4 + 3];
            const float mean = ((pa.x + pb.x) + (pc.x + pd.x)) * (1.f / 256.f); float var = ((pa.y + pb.y) + (pc.y + pd.y)) * (1.f / 256.f) - mean * mean; var = var > 0.f ? var : 0.f;
            const float rstd = 1.0f / sqrtf(var + EPS);
#pragma unroll
            for (int bj = 0; bj < 2; ++bj) { f32x4 s0, s1; unpack8(gv[m][bj], s0, s1);
                const f32x4 o0 = (acc[ai][bj][m][0] - mean) * rstd * gr[bj][0] * s0, o1 = (acc[ai][bj][m][1] - mean) * rstd * gr[bj][1] * s1;
                *(u32x4*)(gp + (size_t)(ai * 128 + m * 16) * D + bj * 128) = pack8(o0, o1); } }
    }
    WG_BAR();
}
__device__ __forceinline__ void epi_state(EPI_ARGS, float* out) {
    const int bh = u.aux, e0 = wc * 32 + 8 * fq;
#pragma unroll
    for (int ai = 0; ai < 2; ++ai) { float* sb = out + (size_t)M * D + (size_t)ai * (32 * 4 * 128 * 256) + (size_t)bh * (128 * 256);
#pragma unroll
        for (int m = 0; m < 4; ++m) { float* rp = sb + (size_t)(wr * 64 + m * 16 + fr) * 256 + e0;
#pragma unroll
            for (int bj = 0; bj < 2; ++bj) { __builtin_nontemporal_store(acc[ai][bj][m][0], (f32x4*)(rp + bj * 128)); __builtin_nontemporal_store(acc[ai][bj][m][1], (f32x4*)(rp + bj * 128 + 4)); } } }
}
__device__ __forceinline__ void epi_spatial(EPI_ARGS, bf16_t* ubuf, const float* b_sp) {
    const int cp = u.pm, g = u.pn, c0 = wc * 32 + 8 * fq;
    bf16_t* up = ubuf + (size_t)(cp * 256 + wr * 64 + fr) * D + g * 256 + c0;
#pragma unroll
    for (int ai = 0; ai < 2; ++ai) {
        u32x4 uv[4][2]; float bs[4];
#pragma unroll
        for (int m = 0; m < 4; ++m) { bs[m] = b_sp[g * 128 + ((wr * 64 + m * 16 + fr) & 127)];
#pragma unroll
            for (int bj = 0; bj < 2; ++bj) uv[m][bj] = *(const u32x4*)(up + (size_t)(ai * 128 + m * 16) * D + bj * 128); }
#pragma unroll
        for (int m = 0; m < 4; ++m)
#pragma unroll
            for (int bj = 0; bj < 2; ++bj) { f32x4 u0, u1; unpack8(uv[m][bj], u0, u1);
                *(u32x4*)(up + (size_t)(ai * 128 + m * 16) * D + bj * 128) = pack8(u0 * (acc[ai][bj][m][0] + bs[m]), u1 * (acc[ai][bj][m][1] + bs[m])); }
    }
}
__device__ __forceinline__ void epi_merge(EPI_ARGS, int kh, const bf16_t* gates, float* tmp, bf16_t* merged) {
    const int row0 = u.pm * 256 + wr * 64 + fr, col0 = u.pn * 256 + wc * 32 + 8 * fq;
#pragma unroll
    for (int ai = 0; ai < 2; ++ai)
#pragma unroll
      for (int mh = 0; mh < 2; ++mh) {
        u32x4 gv[2][2]; f32x4 tv[2][2][2];
#pragma unroll
        for (int mm = 0; mm < 2; ++mm)
#pragma unroll
            for (int bj = 0; bj < 2; ++bj) { const size_t row = (size_t)(row0 + ai * 128 + (mh * 2 + mm) * 16);
                gv[mm][bj] = *(const u32x4*)(gates + row * 2048 + kh * 1024 + col0 + bj * 128);
                if (kh) { const float* tp = tmp + row * D + col0 + bj * 128; tv[mm][bj][0] = *(const f32x4*)tp; tv[mm][bj][1] = *(const f32x4*)(tp + 4); } }
#pragma unroll
        for (int mm = 0; mm < 2; ++mm)
#pragma unroll
            for (int bj = 0; bj < 2; ++bj) { const int m = mh * 2 + mm; const size_t row = (size_t)(row0 + ai * 128 + m * 16); f32x4 g0, g1; unpack8(gv[mm][bj], g0, g1);
                if (kh == 0) { float* tp = tmp + row * D + col0 + bj * 128; *(f32x4*)tp = g0 * acc[ai][bj][m][0]; *(f32x4*)(tp + 4) = g1 * acc[ai][bj][m][1]; }
                else *(u32x4*)(merged + row * D + col0 + bj * 128) = pack8(tv[mm][bj][0] + g0 * acc[ai][bj][m][0], tv[mm][bj][1] + g1 * acc[ai][bj][m][1]); }
      }
}


__device__ __forceinline__ int mod_row(int row);
__device__ __forceinline__ void xchg_rows(LAS unsigned char* xl, const float (&rowss)[2][4], int pm, int pn, int wr, int wc, int fr, int fq, float* slots, unsigned* cnt) {
    LAS float* Pl = (LAS float*)xl; LAS float* S = (LAS float*)(xl + 4096);
    if (fq == 0) {
#pragma unroll
        for (int ai = 0; ai < 2; ++ai)
#pragma unroll
            for (int m = 0; m < 4; ++m) Pl[(ai * 128 + wr * 64 + m * 16 + fr) * 4 + wc] = rowss[ai][m]; }
    WG_BAR();
    const int tid = threadIdx.x;
    if (tid < 256) { const float t = (Pl[tid * 4 + 0] + Pl[tid * 4 + 1]) + (Pl[tid * 4 + 2] + Pl[tid * 4 + 3]);
        __hip_atomic_store(slots + ((size_t)(pm * 256 + tid)) * 4 + pn, t, __ATOMIC_RELAXED, __HIP_MEMORY_SCOPE_AGENT); }
    asm volatile("s_waitcnt vmcnt(0)" ::: "memory");
    WG_BAR();
    if (tid == 0) { unsigned* c = cnt + 16 * pm; __hip_atomic_fetch_add(c, 1u, __ATOMIC_RELAXED, __HIP_MEMORY_SCOPE_AGENT);
        unsigned sp = 0; while (__hip_atomic_load(c, __ATOMIC_RELAXED, __HIP_MEMORY_SCOPE_AGENT) < 4u) { __builtin_amdgcn_s_sleep(2); if (++sp > (1u << 22)) break; }
        __builtin_amdgcn_fence(__ATOMIC_ACQUIRE, "agent"); asm volatile("s_waitcnt vmcnt(0)" ::: "memory"); }
    WG_BAR();
    if (tid < 256) { float* sl = slots + ((size_t)(pm * 256 + tid)) * 4;
        const float t0 = __hip_atomic_load(sl + 0, __ATOMIC_RELAXED, __HIP_MEMORY_SCOPE_AGENT), t1 = __hip_atomic_load(sl + 1, __ATOMIC_RELAXED, __HIP_MEMORY_SCOPE_AGENT),
                    t2 = __hip_atomic_load(sl + 2, __ATOMIC_RELAXED, __HIP_MEMORY_SCOPE_AGENT), t3 = __hip_atomic_load(sl + 3, __ATOMIC_RELAXED, __HIP_MEMORY_SCOPE_AGENT);
        S[tid] = 1.0f / sqrtf(((t0 + t1) + (t2 + t3)) * (1.f / D) + EPS); }
    WG_BAR();
}
__device__ __forceinline__ void row_ssq(const f32x4 (&acc)[2][2][4][2], float (&rowss)[2][4]) {
#pragma unroll
    for (int ai = 0; ai < 2; ++ai)
#pragma unroll
        for (int m = 0; m < 4; ++m) { float s = 0.f;
#pragma unroll
            for (int bj = 0; bj < 2; ++bj)
#pragma unroll
                for (int n = 0; n < 2; ++n) { const f32x4 x = acc[ai][bj][m][n]; s += (x[0] * x[0] + x[1] * x[1]) + (x[2] * x[2] + x[3] * x[3]); }
            s += __shfl_xor(s, 16); s += __shfl_xor(s, 32); rowss[ai][m] = s; }
}
template <bool SRC_IN, bool HAS_H>
__device__ __forceinline__ void epi_norm(f32x4 (&acc)[2][2][4][2], const Unit& u, int wr, int wc, int fr, int fq, LAS unsigned char* xl, const Params& p,
                                         float coef, int ipost, int ig, bf16_t* hout, int ipre, int ish, int isc, int bank) {
    const LAS float* S = (const LAS float*)(xl + 4096);
    float* slots = (float*)(p.ws + WS_XS); unsigned* cnt = (unsigned*)(p.ws + WS_CNT);
    const int rowb = u.pm * 256 + wr * 64 + fr, colb = u.pn * 256 + wc * 32 + 8 * fq;
    const float* mr = (const float*)(p.ws + WS_MOD) + (size_t)mod_row(u.pm * 256) * (NMOD * D);
    const float* xsrc = SRC_IN ? (u.pm < 32 ? p.x_prompt : p.x_sample - (size_t)MP * D) : p.out;
    float rowss[2][4];
    row_ssq(acc, rowss);
    xchg_rows(xl, rowss, u.pm, u.pn, wr, wc, fr, fq, slots, cnt + bank * 1024);
    {
        f32x4 gpo[2][2], mg[2][2];
#pragma unroll
        for (int bj = 0; bj < 2; ++bj)
#pragma unroll
            for (int n = 0; n < 2; ++n) { gpo[bj][n] = *(const f32x4*)(p.g_norm + ipost * D + colb + bj * 128 + 4 * n) * coef; mg[bj][n] = *(const f32x4*)(mr + ig * D + colb + bj * 128 + 4 * n); }
#pragma unroll
        for (int ai = 0; ai < 2; ++ai)
#pragma unroll
            for (int mh = 0; mh < 2; ++mh) {
                f32x4 xv[2][2][2];
#pragma unroll
                for (int mm = 0; mm < 2; ++mm)
#pragma unroll
                    for (int bj = 0; bj < 2; ++bj) { const float* xp = xsrc + (size_t)(rowb + ai * 128 + (mh * 2 + mm) * 16) * D + colb + bj * 128; xv[mm][bj][0] = *(const f32x4*)xp; xv[mm][bj][1] = *(const f32x4*)(xp + 4); }
#pragma unroll
                for (int mm = 0; mm < 2; ++mm) { const int m = mh * 2 + mm; const float rs = S[ai * 128 + wr * 64 + m * 16 + fr];
#pragma unroll
                    for (int bj = 0; bj < 2; ++bj) { float* op = p.out + (size_t)(rowb + ai * 128 + m * 16) * D + colb + bj * 128;
#pragma unroll
                        for (int n = 0; n < 2; ++n) { acc[ai][bj][m][n] = xv[mm][bj][n] + mg[bj][n] * (acc[ai][bj][m][n] * rs * gpo[bj][n]); *(f32x4*)(op + 4 * n) = acc[ai][bj][m][n]; } } }
            }
    }
    if (HAS_H) {
        row_ssq(acc, rowss);
        xchg_rows(xl, rowss, u.pm, u.pn, wr, wc, fr, fq, slots + (size_t)M * 4, cnt + (bank + 1) * 1024);
        f32x4 gpr[2][2], msc[2][2], msh[2][2];
#pragma unroll
        for (int bj = 0; bj < 2; ++bj)
#pragma unroll
            for (int n = 0; n < 2; ++n) { gpr[bj][n] = *(const f32x4*)(p.g_norm + ipre * D + colb + bj * 128 + 4 * n); msc[bj][n] = *(const f32x4*)(mr + isc * D + colb + bj * 128 + 4 * n) + 1.0f; msh[bj][n] = *(const f32x4*)(mr + ish * D + colb + bj * 128 + 4 * n); }
#pragma unroll
        for (int ai = 0; ai < 2; ++ai)
#pragma unroll
            for (int m = 0; m < 4; ++m) { const float rs = S[ai * 128 + wr * 64 + m * 16 + fr];
#pragma unroll
                for (int bj = 0; bj < 2; ++bj) { const f32x4 o0 = acc[ai][bj][m][0] * rs * gpr[bj][0] * msc[bj][0] + msh[bj][0], o1 = acc[ai][bj][m][1] * rs * gpr[bj][1] * msc[bj][1] + msh[bj][1];
                    *(u32x4*)(hout + (size_t)(rowb + ai * 128 + m * 16) * D + colb + bj * 128) = pack8(o0, o1); } }
    }
}


__device__ __forceinline__ int trow192(int ai, int wr, int m, int fr) { return ai ? 128 + wr * 32 + m * 16 + fr : wr * 64 + m * 16 + fr; }
__device__ __forceinline__ void xchg_rows192(LAS unsigned char* xl, const float (&rowss)[2][4], int pm, int pn, int wr, int wc, int fr, int fq, float* slots, unsigned* cnt) {
    LAS float* Pl = (LAS float*)xl; LAS float* S = (LAS float*)(xl + 4096);
    if (fq == 0) {
#pragma unroll
        for (int ai = 0; ai < 2; ++ai)
#pragma unroll
            for (int m = 0; m < (ai ? 2 : 4); ++m) Pl[trow192(ai, wr, m, fr) * 4 + wc] = rowss[ai][m]; }
    WG_BAR();
    const int tid = threadIdx.x;
    if (tid < 192) { const float t = (Pl[tid * 4 + 0] + Pl[tid * 4 + 1]) + (Pl[tid * 4 + 2] + Pl[tid * 4 + 3]);
        __hip_atomic_store(slots + ((size_t)(pm * 192 + tid)) * 4 + pn, t, __ATOMIC_RELAXED, __HIP_MEMORY_SCOPE_AGENT); }
    asm volatile("s_waitcnt vmcnt(0)" ::: "memory");
    WG_BAR();
    if (tid == 0) { unsigned* c = cnt + 16 * pm; __hip_atomic_fetch_add(c, 1u, __ATOMIC_RELAXED, __HIP_MEMORY_SCOPE_AGENT);
        unsigned sp = 0; while (__hip_atomic_load(c, __ATOMIC_RELAXED, __HIP_MEMORY_SCOPE_AGENT) < 4u) { __builtin_amdgcn_s_sleep(2); if (++sp > (1u << 22)) break; }
        __builtin_amdgcn_fence(__ATOMIC_ACQUIRE, "agent"); asm volatile("s_waitcnt vmcnt(0)" ::: "memory"); }
    WG_BAR();
    if (tid < 192) { float* sl = slots + ((size_t)(pm * 192 + tid)) * 4;
        const float t0 = __hip_atomic_load(sl + 0, __ATOMIC_RELAXED, __HIP_MEMORY_SCOPE_AGENT), t1 = __hip_atomic_load(sl + 1, __ATOMIC_RELAXED, __HIP_MEMORY_SCOPE_AGENT),
                    t2 = __hip_atomic_load(sl + 2, __ATOMIC_RELAXED, __HIP_MEMORY_SCOPE_AGENT), t3 = __hip_atomic_load(sl + 3, __ATOMIC_RELAXED, __HIP_MEMORY_SCOPE_AGENT);
        S[tid] = 1.0f / sqrtf(((t0 + t1) + (t2 + t3)) * (1.f / D) + EPS); }
    WG_BAR();
}
__device__ __forceinline__ void row_ssq192(const f32x4 (&acc)[2][2][4][2], float (&rowss)[2][4]) {
#pragma unroll
    for (int ai = 0; ai < 2; ++ai)
#pragma unroll
        for (int m = 0; m < (ai ? 2 : 4); ++m) { float s = 0.f;
#pragma unroll
            for (int bj = 0; bj < 2; ++bj)
#pragma unroll
                for (int n = 0; n < 2; ++n) { const f32x4 x = acc[ai][bj][m][n]; s += (x[0] * x[0] + x[1] * x[1]) + (x[2] * x[2] + x[3] * x[3]); }
            s += __shfl_xor(s, 16); s += __shfl_xor(s, 32); rowss[ai][m] = s; }
}
__device__ __forceinline__ const float* xrow_in(const Params& p, int row);
template <bool SRC_IN, bool HAS_H>
__device__ __forceinline__ void epi_norm192(f32x4 (&acc)[2][2][4][2], const Unit& u, int wr, int wc, int fr, int fq, LAS unsigned char* xl, const Params& p,
                                            float coef, int ipost, int ig, bf16_t* hout, int ipre, int ish, int isc, int bank) {
    const LAS float* S = (const LAS float*)(xl + 4096);
    float* slots = (float*)(p.ws + WS_XS); unsigned* cnt = (unsigned*)(p.ws + WS_CNT);
    const int row0 = u.pm * 192, colb = u.pn * 256 + wc * 32 + 8 * fq;
    const float* modb = (const float*)(p.ws + WS_MOD);
    float rowss[2][4];
    row_ssq192(acc, rowss);
    {
        f32x4 gpo[2][2], xv[2][2][2], mgv[2][2][2];
#pragma unroll
        for (int bj = 0; bj < 2; ++bj)
#pragma unroll
            for (int n = 0; n < 2; ++n) gpo[bj][n] = *(const f32x4*)(p.g_norm + ipost * D + colb + bj * 128 + 4 * n) * coef;
#define EPN_LOADB(AI, MH) do { _Pragma("unroll") for (int mm = 0; mm < 2; ++mm) { const int grow = row0 + trow192(AI, wr, (MH) * 2 + mm, fr); \
            const float* xr = (SRC_IN ? xrow_in(p, grow) : p.out + (size_t)grow * D) + colb; const float* mr = modb + (size_t)mod_row(grow) * (NMOD * D) + ig * D + colb; \
            _Pragma("unroll") for (int bj = 0; bj < 2; ++bj) { xv[mm][bj][0] = *(const f32x4*)(xr + bj * 128); xv[mm][bj][1] = *(const f32x4*)(xr + bj * 128 + 4); mgv[mm][bj][0] = *(const f32x4*)(mr + bj * 128); mgv[mm][bj][1] = *(const f32x4*)(mr + bj * 128 + 4); } } } while (0)
#define EPN_APPLYB(AI, MH) do { _Pragma("unroll") for (int mm = 0; mm < 2; ++mm) { const int m = (MH) * 2 + mm, tr = trow192(AI, wr, m, fr); const float rs = S[tr]; float* op = p.out + (size_t)(row0 + tr) * D + colb; \
            _Pragma("unroll") for (int bj = 0; bj < 2; ++bj) _Pragma("unroll") for (int n = 0; n < 2; ++n) { acc[AI][bj][m][n] = xv[mm][bj][n] + mgv[mm][bj][n] * gpo[bj][n] * (acc[AI][bj][m][n] * rs); if (HAS_H) *(f32x4*)(op + bj * 128 + 4 * n) = acc[AI][bj][m][n]; else __builtin_nontemporal_store(acc[AI][bj][m][n], (f32x4*)(op + bj * 128 + 4 * n)); } } } while (0)
        EPN_LOADB(0, 0);
        xchg_rows192(xl, rowss, u.pm, u.pn, wr, wc, fr, fq, slots, cnt + bank * 1024);
        EPN_APPLYB(0, 0); EPN_LOADB(0, 1); EPN_APPLYB(0, 1); EPN_LOADB(1, 0); EPN_APPLYB(1, 0);
#undef EPN_LOADB
#undef EPN_APPLYB
    }
    if (HAS_H) {
        row_ssq192(acc, rowss);
        f32x4 gpr[2][2];
#pragma unroll
        for (int bj = 0; bj < 2; ++bj)
#pragma unroll
            for (int n = 0; n < 2; ++n) gpr[bj][n] = *(const f32x4*)(p.g_norm + ipre * D + colb + bj * 128 + 4 * n);
        xchg_rows192(xl, rowss, u.pm, u.pn, wr, wc, fr, fq, slots + (size_t)M * 4, cnt + (bank + 1) * 1024);
#pragma unroll
        for (int ai = 0; ai < 2; ++ai)
#pragma unroll
            for (int m = 0; m < (ai ? 2 : 4); ++m) { const int tr = trow192(ai, wr, m, fr), grow = row0 + tr; const float rs = S[tr];
                const float* mr = modb + (size_t)mod_row(grow) * (NMOD * D) + colb;
#pragma unroll
                for (int bj = 0; bj < 2; ++bj) { const f32x4 sc0 = *(const f32x4*)(mr + isc * D + bj * 128), sc1 = *(const f32x4*)(mr + isc * D + bj * 128 + 4), sh0 = *(const f32x4*)(mr + ish * D + bj * 128), sh1 = *(const f32x4*)(mr + ish * D + bj * 128 + 4);
                    const f32x4 o0 = acc[ai][bj][m][0] * rs * gpr[bj][0] * (sc0 + 1.0f) + sh0, o1 = acc[ai][bj][m][1] * rs * gpr[bj][1] * (sc1 + 1.0f) + sh1;
                    *(u32x4*)(hout + (size_t)grow * D + colb + bj * 128) = pack8(o0, o1); } }
    }
}
struct SchedT192 {
    const char* A; const char* B; unsigned lda, ldb; int nt, G, c;
    __device__ __forceinline__ bool next(int i, Unit& u) const {
        const long L = (long)i * G + c; if (L >= 256) return false;
        int pm, pn; tile_map((int)L, 64, 4, pm, pn);
        u.a = A + (size_t)pm * 192 * lda; u.b = B + (size_t)pn * 256 * ldb; u.lda = lda; u.ldb = ldb; u.nt = nt; u.kind = K_F32; u.pm = pm; u.pn = pn; u.aux = 0; return true;
    }
};
template <int PH> struct Epi {
    Params p; LAS unsigned char* xl;
    __device__ __forceinline__ void operator()(f32x4 (&acc)[2][2][4][2], const Unit& u, int wr, int wc, int fr_, int fq_) const {
        unsigned char* ws = p.ws;
        int fr = fr_, fq = fq_; asm volatile("" : "+v"(fr), "+v"(fq));
        if constexpr (PH == 2) { epi_swiglu(acc, u, wr, wc, fr, fq, (bf16_t*)(ws + WS_ACT)); return; }
        if constexpr (PH == 3) { epi_norm192<true, true>(acc, u, wr, wc, fr, fq, xl, p, 0.5f, 1, 2, (bf16_t*)((unsigned char*)p.out + OUT_H2), 2, 3, 4, 0); return; }
        if constexpr (PH == 9) { epi_norm192<false, true>(acc, u, wr, wc, fr, fq, xl, p, 1.0f, 3, 5, (bf16_t*)(ws + WS_H3), 4, 6, 7, 2); return; }
        if constexpr (PH == 12) { epi_norm192<false, false>(acc, u, wr, wc, fr, fq, xl, p, 0.5f, 5, 8, nullptr, 0, 0, 0, 4); return; }
        const int kind = PH == 5 ? (u.kind < K_QK ? K_QK : (u.kind > K_KT ? K_KT : u.kind)) : PH == 6 ? ((u.kind == K_VT || u.kind == K_KT) ? u.kind : K_SC_P) : PH == 7 ? (u.kind < K_PV_P ? K_PV_P : (u.kind > K_SPATIAL ? K_SPATIAL : u.kind)) : (u.kind == K_MERGE0 ? K_MERGE0 : K_MERGE1);
        switch (kind) {
        case K_SWIGLU: epi_swiglu(acc, u, wr, wc, fr, fq, (bf16_t*)(ws + WS_ACT)); break;
        case K_QK: epi_qk(acc, u, wr, wc, fr, fq, (bf16_t*)(ws + (u.pn < 2 ? WS_Q : WS_K)), u.pn < 2 ? 0.08838834764831845f : 1.0f, (const float*)(ws + WS_ROPE)); break;
        case K_G: epi_act<0>(acc, u, wr, wc, fr, fq, (bf16_t*)(ws + WS_G), D, u.aux * 256); break;
        case K_U: epi_act<1>(acc, u, wr, wc, fr, fq, (bf16_t*)(ws + WS_U), D, u.aux * 256); break;
        case K_GATES: epi_act<2>(acc, u, wr, wc, fr, fq, (bf16_t*)(ws + WS_GATES), 2048, u.aux * 256); break;
        case K_VT: epi_vt(acc, u, wr, wc, fr, fq, (bf16_t*)(ws + WS_VTP), (bf16_t*)(ws + WS_VTS)); break;
        case K_GVT: epi_gvt(acc, u, wr, wc, fr, fq, (bf16_t*)(ws + WS_GVT)); break;
        case K_KT: epi_kt(acc, u, wr, wc, fr, fq, (bf16_t*)(ws + WS_KT), (const float*)(ws + WS_LG)); break;
        case K_SC_P: case K_SC_S: { const bool sm = u.kind == K_SC_S; const int bh = sm ? (u.aux >> 4) : u.aux, h = bh & 3, qi = sm ? ((u.aux >> 2) & 3) : 0, ki = sm ? (u.aux & 3) : 0;
            const float* lgt = (const float*)(ws + WS_LG);
            epi_scores(acc, u, wr, wc, fr, fq, sm ? (bf16_t*)(ws + WS_PS) + (size_t)bh * (1024 * 1280) : (bf16_t*)(ws + WS_PP) + (size_t)bh * 65536, sm ? 1280 : 256, qi * 256, ki * 256, lgt[h], lgt[4 + h]); } break;
        case K_PV_P: { const int bh = u.aux; epi_pv(acc, u, wr, wc, fr, fq, xl, (bf16_t*)(ws + WS_G), p.g_ret, (bh >> 2) * 256, bh & 3); } break;
        case K_PV_S: { const int bh = u.aux >> 2, qi = u.aux & 3; epi_pv(acc, u, wr, wc, fr, fq, xl, (bf16_t*)(ws + WS_G), p.g_ret, MP + (bh >> 2) * 1024 + qi * 256, bh & 3); } break;
        case K_STATE: epi_state(acc, u, wr, wc, fr, fq, p.out); break;
        case K_SPATIAL: epi_spatial(acc, u, wr, wc, fr, fq, (bf16_t*)(ws + WS_U), p.b_sp); break;
        case K_MERGE0: epi_merge(acc, u, wr, wc, fr, fq, 0, (const bf16_t*)(ws + WS_GATES), (float*)(ws + WS_TMP), (bf16_t*)(ws + WS_MERGED)); break;
        case K_MERGE1: epi_merge(acc, u, wr, wc, fr, fq, 1, (const bf16_t*)(ws + WS_GATES), (float*)(ws + WS_TMP), (bf16_t*)(ws + WS_MERGED)); break;
        default: break;
        }
    }
};

struct SchedSimple {
    const char* A; const char* B; unsigned lda, ldb; int nM, nN, nt, kind, aux, G, c;
    __device__ __forceinline__ bool next(int i, Unit& u) const {
        const long L = (long)i * G + c; if (L >= nM * nN) return false;
        int pm, pn; tile_map((int)L, nM, nN, pm, pn);
        u.a = A + (size_t)pm * 256 * lda; u.b = B + (size_t)pn * 256 * ldb; u.lda = lda; u.ldb = ldb; u.nt = nt; u.kind = kind; u.pm = pm; u.pn = pn; u.aux = aux; return true;
    }
};
struct SchedIn {
    const char* H; const char* W; int G, c;
    __device__ __forceinline__ bool next(int i, Unit& u) const {
        long L = (long)i * G + c; u.lda = 2048; u.ldb = 2048; u.nt = 16;
        if (L < 960) { int pm, ct; tile_map((int)L, 48, 20, pm, ct);
            int wrow, kind, aux;
            if (ct < 4) { wrow = ct * 256; kind = K_QK; aux = ct & 1; }
            else if (ct < 8) { wrow = 2048 + (ct - 4) * 256; kind = K_G; aux = ct - 4; }
            else if (ct < 12) { wrow = 3072 + (ct - 8) * 256; kind = K_U; aux = ct - 8; }
            else { wrow = 5120 + (ct - 12) * 256; kind = K_GATES; aux = ct - 12; }
            u.a = H + (size_t)pm * 256 * 2048; u.b = W + (size_t)wrow * 2048; u.kind = kind; u.pm = pm; u.pn = ct; u.aux = aux; return true; }
        L -= 960;
        if (L < 192) { int wt, tt; tile_map((int)L, 4, 48, wt, tt);
            u.a = W + (size_t)(4096 + wt * 256) * 2048; u.b = H + (size_t)tt * 256 * 2048; u.kind = K_GVT; u.pm = wt + 4; u.pn = tt; u.aux = 0; return true; }
        L -= 192;
        if (L < 128) { int wt, tt; tile_map((int)L, 4, 32, wt, tt);
            u.a = W + (size_t)(1024 + wt * 256) * 2048; u.b = H + (size_t)tt * 256 * 2048; u.kind = K_VT; u.pm = wt; u.pn = tt; u.aux = 0; return true; }
        return false;
    }
};
struct SchedScores {
    const char* Q; const char* Kb; const char* H; const char* W; int G, c;
    __device__ __forceinline__ bool fill(int L, Unit& u) const {
        const bool big = L < 128, isvt = L < 64;
        int hp, tk; tile_map(big && !isvt ? L - 64 : 0, 2, 32, hp, tk);
        const int wt = L & 3, tv = 32 + (L >> 2);
        const size_t wrow = isvt ? (size_t)(1024 + wt * 256) : (size_t)(512 + hp * 256);
        const int ttok = isvt ? tv : tk;
        const int Ls = L - 128; const bool smp = Ls < 256; const int idx = smp ? Ls : Ls - 256;
        const int bh = smp ? (idx >> 4) : idx, b = bh >> 2, h = bh & 3, qi = smp ? ((idx >> 2) & 3) : 0, ki = smp ? (idx & 3) : 0;
        const size_t qrow = smp ? (size_t)(MP + b * 1024 + qi * 256) : (size_t)(b * 256), krow = smp ? (size_t)(MP + b * 1024 + ki * 256) : (size_t)(b * 256);
        const char* sa = Q + (qrow * 512 + h * 128) * 2; const char* sb = Kb + (krow * 512 + h * 128) * 2;
        const char* ba = W + wrow * 2048; const char* bb = H + (size_t)ttok * 256 * 2048;
        u.a = big ? ba : sa; u.b = big ? bb : sb; u.lda = big ? 2048u : 1024u; u.ldb = u.lda; u.nt = big ? 16 : 2;
        u.kind = big ? (isvt ? K_VT : K_KT) : (smp ? K_SC_S : K_SC_P); u.pm = big ? (isvt ? wt : hp) : 0; u.pn = big ? ttok : 0; u.aux = big ? 0 : idx;
        return true;
    }
    __device__ __forceinline__ bool next(int i, Unit& u) const {
        if (G == 256) { if (c < 128) return i == 0 ? fill(c, u) : false; if (c < 192) return i < 2 ? fill(128 + (c - 128) * 2 + i, u) : false; return i < 4 ? fill(256 + (c - 192) * 4 + i, u) : false; }
        const long L = (long)i * G + c; return L < 512 ? fill((int)L, u) : false;
    }
};
struct SchedMix {
    const unsigned char* ws; int G, c;
    __device__ __forceinline__ bool fill(int L, Unit& u) const {
        if (L < 64) { const int bh = L >> 2, b = bh >> 2, h = bh & 3, qi = L & 3;
            u.a = (const char*)ws + WS_PS + ((size_t)(bh * 1024 + qi * 256) * 1280) * 2; u.lda = 2560; u.b = (const char*)ws + WS_VTS + ((size_t)(b * 1024 + h * 256) * 1280) * 2; u.ldb = 2560;
            u.nt = 20; u.kind = K_PV_S; u.pm = 0; u.pn = 0; u.aux = L; return true; }
        L -= 64;
        if (L < 128) { const int bh = L, b = bh >> 2, h = bh & 3;
            u.a = (const char*)ws + WS_PP + (size_t)bh * 131072; u.lda = 512; u.b = (const char*)ws + WS_VTP + ((size_t)(h * 256) * LD_VTP + b * 256) * 2; u.ldb = LD_VTP * 2;
            u.nt = 4; u.kind = K_PV_P; u.pm = 0; u.pn = 0; u.aux = bh; return true; }
        L -= 128;
        if (L < 128) { const int bh = L, b = bh >> 2, h = bh & 3;
            u.a = (const char*)ws + WS_KT + ((size_t)(h * 256) * LD_KT + b * 256) * 2; u.lda = LD_KT * 2; u.b = (const char*)ws + WS_VTP + ((size_t)(h * 256) * LD_VTP + b * 256) * 2; u.ldb = LD_VTP * 2;
            u.nt = 4; u.kind = K_STATE; u.pm = 0; u.pn = 0; u.aux = bh; return true; }
        L -= 128;
        if (L < 192) { const int cp = L >> 2, g = L & 3;
            u.a = (const char*)ws + WS_BD + (size_t)g * 131072; u.lda = 512; u.b = (const char*)ws + WS_GVT + ((size_t)(g * 256) * LD_GVT + cp * 256) * 2; u.ldb = LD_GVT * 2;
            u.nt = 4; u.kind = K_SPATIAL; u.pm = cp; u.pn = g; u.aux = 0; return true; }
        return false;
    }
    __device__ __forceinline__ bool next(int i, Unit& u) const {
        if (G >= 128) { if (c < 64) return i == 0 ? fill(c, u) : false; const long L = 64 + (long)i * (G - 64) + (c - 64); return L < 512 ? fill((int)L, u) : false; }
        const long L = (long)i * G + c; return L < 512 ? fill((int)L, u) : false;
    }
};
struct SchedSwiglu {
    const char* A; const char* B; int G, c;
    __device__ __forceinline__ bool next(int i, Unit& u) const {
        const bool sp = (G == 256); const bool halfu = sp && i == 4;
        const long L = halfu ? (long)(1024 + (c >> 1)) : (long)i * G + c;
        const bool valid = halfu ? (c < 64) : (L < (sp ? 1024 : 1056));
        int pm, pn; tile_map(valid ? (int)L : 0, 48, 22, pm, pn);
        const int ro = halfu ? (c & 1) * 128 : 0;
        u.a = A + ((size_t)pm * 256 + ro) * 2048; u.b = B + (size_t)pn * 256 * 2048; u.lda = 2048; u.ldb = 2048; u.nt = 16; u.kind = halfu ? K_SWIGLU_H : K_SWIGLU; u.pm = pm; u.pn = pn; u.aux = ro;
        return valid && (!sp || i < 5);
    }
};
struct SchedMerge {
    const unsigned char* ws; int G, c;
    __device__ __forceinline__ bool next(int i, Unit& u) const {
        const long L = (long)(i >> 1) * G + c; if (L >= 192) return false; const int kh = i & 1;
        int pm, pn; tile_map((int)L, 48, 4, pm, pn);
        u.a = (const char*)ws + (kh ? WS_U : WS_G) + (size_t)pm * 256 * 2048; u.b = (const char*)ws + (kh ? WS_WS : WS_WR) + (size_t)pn * 256 * 2048; u.lda = 2048; u.ldb = 2048; u.nt = 16;
        u.kind = kh ? K_MERGE1 : K_MERGE0; u.pm = pm; u.pn = pn; u.aux = 0; return true;
    }
};

__device__ __forceinline__ void transpose_item(const float* W, int K, int N, bf16_t* WT, int dstrow0, LAS float* scr, int k0, int n0, int lane) {
#pragma unroll
    for (int i = 0; i < 32; ++i) { const int kk = 2 * i + (lane >> 5); scr[kk * 33 + (lane & 31)] = __builtin_nontemporal_load(W + (size_t)(k0 + kk) * N + n0 + (lane & 31)); }
    LDS_WAIT();
    const int c = lane & 7;
#pragma unroll
    for (int j = 0; j < 4; ++j) { const int n = (lane >> 3) + 8 * j; const LAS float* s = scr + (8 * c) * 33 + n;
        u32x4 o; o.x = cvt_pk_bf16(s[0 * 33], s[1 * 33]); o.y = cvt_pk_bf16(s[2 * 33], s[3 * 33]); o.z = cvt_pk_bf16(s[4 * 33], s[5 * 33]); o.w = cvt_pk_bf16(s[6 * 33], s[7 * 33]);
        *(u32x4*)(WT + (size_t)(dstrow0 + n) * K + k0 + 8 * c) = o; }
    LDS_WAIT();
}
template <int MODE> __device__ __forceinline__ void conv_matrix(const float* W, int K, int N, bf16_t* WT, LAS float* scr, int gw, int NGW, int lane) {
    const int nblk = N / 32, nitems = (K / 64) * nblk;
    for (int it = gw; it < nitems; it += NGW) { const int kb = it / nblk, nb = it % nblk, n0 = nb * 32; int dr = n0;
        if (MODE == 1) { const int half = n0 / FF, cidx = n0 % FF; dr = (cidx >> 7) * 256 + half * 128 + (cidx & 127); }
        if (MODE == 2) { if (n0 < 1024) { const int seg = n0 >> 9, r = n0 & 511, head = r >> 7, dim = r & 127; dr = (seg * 2 + (head >> 1)) * 256 + (dim >> 6) * 128 + (head & 1) * 64 + (dim & 63); } }
        transpose_item(W, K, N, WT, dr, scr, kb * 64, n0, lane); }
}
__device__ __forceinline__ void conv_wkv(const float* W, bf16_t* WT, LAS float* scr, int gw, int NGW, int lane) {
    const int nblk = 1536 / 32, nitems = (D / 64) * nblk;
    for (int it = gw; it < nitems; it += NGW) { const int kb = it / nblk, nb = it % nblk, n0 = 512 + nb * 32; int dr = n0;
        if (n0 < 1024) { const int seg = n0 >> 9, r = n0 & 511, head = r >> 7, dim = r & 127; dr = (seg * 2 + (head >> 1)) * 256 + (dim >> 6) * 128 + (head & 1) * 64 + (dim & 63); }
        transpose_item(W, D, 7168, WT, dr - 512, scr, kb * 64, n0, lane); }
}
__device__ __forceinline__ const float* xrow_in(const Params& p, int row) { return row < MP ? p.x_prompt + (size_t)row * D : p.x_sample + (size_t)(row - MP) * D; }
__device__ __forceinline__ int mod_row(int row) { return row < MP ? 0 : 1 + ((row - MP) >> 10); }

template <bool HAS_F, bool HAS_H>
__device__ __forceinline__ void norm_pass(const Params& p, const float* xsrc_out  , const bf16_t* f, float coef, int ipost, int ig, bf16_t* hout, int ipre, int ish, int isc, int gw, int NGW, int lane) {
    const float* mod = (const float*)(p.ws + WS_MOD);
    f32x4 gpo[4], gpr[4], mg[4], msc[4], msh[4];
#pragma unroll
    for (int j = 0; j < 4; ++j) { if (HAS_F) gpo[j] = *(const f32x4*)(p.g_norm + ipost * D + 4 * lane + 256 * j); if (HAS_H) gpr[j] = *(const f32x4*)(p.g_norm + ipre * D + 4 * lane + 256 * j); }
    int cur_mr = -1;
    f32x4 v[4], nv[4]; u32x2 fv[4], nfv[4];
    int row = gw;
    if (row < M) { const float* xr = xsrc_out ? xsrc_out + (size_t)row * D : xrow_in(p, row);
#pragma unroll
        for (int j = 0; j < 4; ++j) { nv[j] = *(const f32x4*)(xr + 4 * lane + 256 * j); if (HAS_F) nfv[j] = *(const u32x2*)(f + (size_t)row * D + 4 * lane + 256 * j); } }
    for (; row < M; row += NGW) {
#pragma unroll
        for (int j = 0; j < 4; ++j) { v[j] = nv[j]; if (HAS_F) fv[j] = nfv[j]; }
        const int nrow = row + NGW;
        if (nrow < M) { const float* xr = xsrc_out ? xsrc_out + (size_t)nrow * D : xrow_in(p, nrow);
#pragma unroll
            for (int j = 0; j < 4; ++j) { nv[j] = *(const f32x4*)(xr + 4 * lane + 256 * j); if (HAS_F) nfv[j] = *(const u32x2*)(f + (size_t)nrow * D + 4 * lane + 256 * j); } }
        const int mrow = mod_row(row);
        if (mrow != cur_mr) { cur_mr = mrow; const float* mr = mod + (size_t)mrow * (NMOD * D);
#pragma unroll
            for (int j = 0; j < 4; ++j) { if (HAS_F) mg[j] = *(const f32x4*)(mr + ig * D + 4 * lane + 256 * j);
                if (HAS_H) { msc[j] = *(const f32x4*)(mr + isc * D + 4 * lane + 256 * j); msh[j] = *(const f32x4*)(mr + ish * D + 4 * lane + 256 * j); } } }
        if (HAS_F) {
            f32x4 ff[4]; float ss = 0.f;
#pragma unroll
            for (int j = 0; j < 4; ++j) { ff[j] = (f32x4){__uint_as_float(fv[j].x << 16), __uint_as_float(fv[j].x & 0xffff0000u), __uint_as_float(fv[j].y << 16), __uint_as_float(fv[j].y & 0xffff0000u)};
                ss += (ff[j][0] * ff[j][0] + ff[j][1] * ff[j][1]) + (ff[j][2] * ff[j][2] + ff[j][3] * ff[j][3]); }
            const float rs = coef / sqrtf(wave_sum(ss) * (1.f / D) + EPS);
#pragma unroll
            for (int j = 0; j < 4; ++j) { v[j] = v[j] + mg[j] * (ff[j] * rs * gpo[j]); *(f32x4*)(p.out + (size_t)row * D + 4 * lane + 256 * j) = v[j]; }
        }
        if (HAS_H) {
            float ss = 0.f;
#pragma unroll
            for (int j = 0; j < 4; ++j) ss += (v[j][0] * v[j][0] + v[j][1] * v[j][1]) + (v[j][2] * v[j][2] + v[j][3] * v[j][3]);
            const float rs = 1.0f / sqrtf(wave_sum(ss) * (1.f / D) + EPS);
#pragma unroll
            for (int j = 0; j < 4; ++j) { const f32x4 o = v[j] * rs * gpr[j] * (1.0f + msc[j]) + msh[j]; u32x2 w; w.x = cvt_pk_bf16(o[0], o[1]); w.y = cvt_pk_bf16(o[2], o[3]);
                *(u32x2*)(hout + (size_t)row * D + 4 * lane + 256 * j) = w; }
        }
    }
}

#define XB_TMO      128
#define XB_XCNT(j)  (256  + 64 * (j))
#define XB_XSUB(j)  (1280 + 64 * (j))
#define XB_XGEN(j)  (2304 + 64 * (j))
#define XB_TOP      3328
#define XB_TOPGEN   3392
#define XCD_BAR_WORDS 3456
#define XB_SPIN_CAP (1u << 22)

__device__ __forceinline__ unsigned xb_ld(unsigned* p)              { return __hip_atomic_load(p, __ATOMIC_RELAXED, __HIP_MEMORY_SCOPE_AGENT); }
__device__ __forceinline__ unsigned xb_add(unsigned* p, unsigned v) { return __hip_atomic_fetch_add(p, v, __ATOMIC_RELAXED, __HIP_MEMORY_SCOPE_AGENT); }
__device__ __forceinline__ unsigned xb_xcc_id() { return (unsigned)__builtin_amdgcn_s_getreg((3 << 11) | 20) & 0xFu; }
#define XB_SPIN(cond, bar) do { unsigned _sp = 0; while (cond) { __builtin_amdgcn_s_sleep(1); \
    if ((++_sp & 255u) == 0u) { if (xb_ld(&(bar)[XB_TMO])) break; if (_sp > XB_SPIN_CAP) { atomicAdd(&(bar)[XB_TMO], 1u); break; } } } } while (0)

struct XcdBarrier {
    unsigned* bar; unsigned x;
    volatile LAS unsigned* st;
};

__device__ __forceinline__ XcdBarrier xcd_barrier_post(unsigned* bar, volatile LAS unsigned* st) {
    XcdBarrier b; b.bar = bar; b.x = xb_xcc_id(); b.st = st;
    if (threadIdx.x == 0) (void)xb_add(&bar[XB_XCNT(b.x)], 1u);
    return b;
}
__device__ __forceinline__ void xcd_barrier_complete(unsigned* bar, unsigned x, unsigned& nloc, unsigned& nx) {
    const unsigned G = gridDim.x * gridDim.y * gridDim.z;
    unsigned sum, cnt, mine, sp = 0u;
    for (;;) {
        sum = 0u; cnt = 0u; mine = 0u;
#pragma unroll
        for (unsigned j = 0; j < 16; ++j) { const unsigned c = xb_ld(&bar[XB_XCNT(j)]); sum += c; cnt += (c > 0u) ? 1u : 0u; mine = (j == x) ? c : mine; }
        if (sum == G) break;
        __builtin_amdgcn_s_sleep(1);
        if ((++sp & 255u) == 0u) { if (xb_ld(&bar[XB_TMO])) break; if (sp > XB_SPIN_CAP) { atomicAdd(&bar[XB_TMO], 1u); break; } }
    }
    nloc = mine > 0u ? mine : 1u; nx = cnt > 0u ? cnt : 1u;
}

__device__ __forceinline__ void xcd_barrier(const XcdBarrier& b) {
    asm volatile("s_waitcnt vmcnt(0)" ::: "memory");
    __syncthreads();
    if (threadIdx.x == 0) {
        unsigned* bar = b.bar;
        __builtin_amdgcn_s_waitcnt(0);
        unsigned nloc = b.st[0], nx = b.st[1];
        if (nloc == 0u) { xcd_barrier_complete(bar, b.x, nloc, nx); b.st[0] = nloc; b.st[1] = nx; }
        const unsigned old = xb_add(&bar[XB_XSUB(b.x)], 1u);
        const unsigned gen = old / nloc;
        if (old + 1u == (gen + 1u) * nloc) {
            __builtin_amdgcn_fence(__ATOMIC_RELEASE, "agent");
            asm volatile("s_waitcnt vmcnt(0)" ::: "memory");
            const unsigned og = xb_add(&bar[XB_TOP], 1u);
            const unsigned tg = og / nx;
            if (og + 1u == (tg + 1u) * nx) xb_add(&bar[XB_TOPGEN], 1u);
            else XB_SPIN(xb_ld(&bar[XB_TOPGEN]) == tg, bar);
            __builtin_amdgcn_fence(__ATOMIC_ACQUIRE, "agent");
            xb_add(&bar[XB_XGEN(b.x)], 1u);
            asm volatile("s_waitcnt vmcnt(0)" ::: "memory");
        } else {
            XB_SPIN(xb_ld(&bar[XB_XGEN(b.x)]) == gen, bar);
            __builtin_amdgcn_fence(__ATOMIC_ACQUIRE, "agent");
            asm volatile("s_waitcnt vmcnt(0)" ::: "memory");
        }
    }
    __syncthreads();
}

__global__ void __launch_bounds__(512, 2) fwd_kernel(Params pa) {
    extern __shared__ __attribute__((aligned(16))) unsigned char lds_raw[];
    LAS unsigned char* lds = (LAS unsigned char*)lds_raw;
    cg::grid_group grid = cg::this_grid();
    const int G = gridDim.x, bid = blockIdx.x, NGW = G * 8, NGT = G * 512;
    const int lo = pa.ph_lo, hi = pa.ph_hi;
    typedef const __attribute__((address_space(4))) Params* KParamsPtr;
    const KParamsPtr kp = (KParamsPtr)__builtin_amdgcn_kernarg_segment_ptr();
#define LOADP KParamsPtr kq = kp; asm volatile("" : "+s"(kq)); Params p; __builtin_memcpy(&p, kq, sizeof(Params)); unsigned char* const ws = p.ws; \
    int tid_ = threadIdx.x; asm volatile("" : "+v"(tid_)); const int tid = tid_, lane = tid & 63, wave = __builtin_amdgcn_readfirstlane(tid >> 6), gw = bid * 8 + wave, gt = bid * 512 + tid; \
    LAS float* const scr = (LAS float*)(lds + wave * 16384); (void)lane; (void)gw; (void)gt; (void)scr
#ifndef PH_MASK
#define PH_MASK 0xffff
#endif
#define IN(k) (((PH_MASK >> (k)) & 1) && ((lo >> (k)) & 1))
#define SEAM(k) do { if (hi) xcd_barrier(bar); } while (0)
    if (pa.ph_hi > 1000) grid.sync();
    if (threadIdx.x < 8) ((LAS unsigned*)(lds + MISC_OFF))[threadIdx.x] = 0u;
    __syncthreads();
    XcdBarrier bar = xcd_barrier_post((unsigned*)(pa.ws + WS_BAR), (volatile LAS unsigned*)(lds + MISC_OFF));
    LAS unsigned char* const xl = lds + XL_OFF;

#ifdef NANFILL
    {
        u32x4* wsv = (u32x4*)pa.ws; const u32x4 ff = (u32x4){0xffffffffu, 0xffffffffu, 0xffffffffu, 0xffffffffu};
        const size_t lo_skip = WS_BAR / 16, hi_skip = (WS_BAR + 16384) / 16;
        for (size_t e = gt; e < WS_END / 16; e += NGT) if (e < lo_skip || e >= hi_skip) wsv[e] = ff;
        xcd_barrier(bar);
    }
#endif
    if (IN(0)) { LOADP;
        if (bid < 144) {
            LAS float* sc = (LAS float*)lds; LAS float* red = (LAS float*)(lds + 20480);
            for (int e = tid; e < 5 * D; e += 512) { const int r = e >> 10, k = e & 1023; const float x = r == 0 ? p.c_ctx[k] : p.c[(r - 1) * D + k]; sc[e] = x / (1.0f + expf(-x)); }
            __syncthreads();
            for (int it = bid; it < 144; it += G) {
                float a0 = 0.f, a1 = 0.f, a2 = 0.f, a3 = 0.f, a4 = 0.f; const float* wp = p.w_ada + (size_t)(wave * 128) * (NMOD * D) + it * 64 + lane;
#pragma unroll 16
                for (int k = 0; k < 128; ++k) { const float w = __builtin_nontemporal_load(wp + (size_t)k * (NMOD * D)); const int kk = wave * 128 + k;
                    a0 += sc[kk] * w; a1 += sc[1024 + kk] * w; a2 += sc[2048 + kk] * w; a3 += sc[3072 + kk] * w; a4 += sc[4096 + kk] * w; }
                red[(wave * 5 + 0) * 64 + lane] = a0; red[(wave * 5 + 1) * 64 + lane] = a1; red[(wave * 5 + 2) * 64 + lane] = a2; red[(wave * 5 + 3) * 64 + lane] = a3; red[(wave * 5 + 4) * 64 + lane] = a4;
                __syncthreads();
                if (tid < 320) { const int r = tid >> 6, l = tid & 63; float s = p.b_ada[it * 64 + l];
#pragma unroll
                    for (int w = 0; w < 8; ++w) s += red[(w * 5 + r) * 64 + l];
                    ((float*)(ws + WS_MOD))[(size_t)r * (NMOD * D) + it * 64 + l] = s; }
                __syncthreads();
            }
        }
        __syncthreads();
        {
            const bool spare = G > 176; const int cgw = spare ? (bid - 144) * 8 + wave : gw, cng = spare ? (G - 144) * 8 : NGW;
            if (!spare || bid >= 144) {
                conv_matrix<1>(p.w_ffn1_in, D, 2 * FF, (bf16_t*)(ws + WS_W1), scr, cgw, cng, lane);
                conv_matrix<0>(p.w_ffn1_out, FF, D, (bf16_t*)(ws + WS_W2), scr, cgw, cng, lane); } }
        if (gt < 8) ((float*)(ws + WS_LG))[gt] = lg2_decay_slow(p.decay, gt);
        for (int e = gt; e < 1024 * 64; e += NGT) {
            const int pos = e >> 6, pp = e & 63; const float freq = exp2f(-(float)(pp & 31) * (13.287712379549449f / 32.0f));
            const float ang = (float)(pp < 32 ? (pos >> 6) : (pos & 63)) * freq; float rev = ang * 0.15915494309189535f; rev -= floorf(rev);
            ((f32x2*)(ws + WS_ROPE))[e] = (f32x2){__builtin_amdgcn_cosf(rev), __builtin_amdgcn_sinf(rev)};
        }
        for (int e = gt; e < 4 * 256 * 256 / 2; e += NGT) {
            const int g = e >> 15, r = (e >> 7) & 255, c2 = (e & 127) * 2; float v0 = 0.f, v1 = 0.f;
            if ((r >> 7) == (c2 >> 7)) { const float* wp = p.w_sp + ((size_t)g * 128 + (r & 127)) * 128 + (c2 & 127); v0 = wp[0]; v1 = wp[1]; }
            ((unsigned*)(ws + WS_BD))[e] = cvt_pk_bf16(v0, v1);
        }
    }
    SEAM(0);
    if (IN(1)) { LOADP;
        norm_pass<false, true>(p, nullptr, nullptr, 0.f, 0, 0, (bf16_t*)(ws + WS_H), 0, 0, 1, gw, NGW, lane); }
    SEAM(1);
    if (IN(2)) { LOADP;  SchedSwiglu S{(const char*)(ws + WS_H), (const char*)(ws + WS_W1), G, bid}; Epi<2> E{p, xl}; gemm_phase<Epi<2>, SchedSwiglu, false, true>(lds, S, E);
        {
            const bool spare = (G == 256); const int cgw = spare ? (bid - 64) * 8 + wave : gw, cng = spare ? (G - 64) * 8 : NGW;
            if (!spare || bid >= 64) { __syncthreads();
                conv_matrix<2>(p.w_in, D, 7168, (bf16_t*)(ws + WS_WIN), scr, cgw, cng, lane);
                conv_wkv(p.w_in, (bf16_t*)((unsigned char*)p.out + OUT_WKV), scr, cgw, cng, lane);
                conv_matrix<0>(p.w_ret_br, D, D, (bf16_t*)(ws + WS_WR), scr, cgw, cng, lane);
                conv_matrix<0>(p.w_sg_br, D, D, (bf16_t*)(ws + WS_WS), scr, cgw, cng, lane);
                conv_matrix<0>(p.w_out, D, D, (bf16_t*)(ws + WS_WO), scr, cgw, cng, lane); } } }
    SEAM(2);
    if (IN(3)) { LOADP;  SchedT192 S{(const char*)(ws + WS_ACT), (const char*)(ws + WS_W2), FF * 2, FF * 2, 44, G, bid}; Epi<3> E{p, xl}; gemm_phase<Epi<3>, SchedT192, true>(lds, S, E); }
    SEAM(3);
    if (IN(5)) { LOADP;  SchedIn S{(const char*)p.out + OUT_H2, (const char*)(ws + WS_WIN), G, bid}; Epi<5> E{p, xl}; gemm_phase(lds, S, E); }
    SEAM(5);
    if (IN(6)) { LOADP;
        { SchedScores S{(const char*)(ws + WS_Q), (const char*)(ws + WS_K), (const char*)p.out + OUT_H2, (const char*)p.out + OUT_WKV - (size_t)512 * 2048, G, bid}; Epi<6> E{p, xl}; gemm_phase(lds, S, E); }
        __syncthreads();
#ifndef NO_P6_PASSES
        {
            bf16_t* gvt = (bf16_t*)(ws + WS_GVT); LAS float* red = (LAS float*)lds;
            const int rsub = tid >> 3, c8 = tid & 7;
            for (int it = (G == 256 ? (bid < 192 ? bid : M / 64) : bid); it < M / 64; it += G) {
                const int t0 = it * 64 + 8 * c8; float s[8], q[8];
#pragma unroll
                for (int j = 0; j < 8; ++j) { s[j] = 0.f; q[j] = 0.f; }
#pragma unroll 4
                for (int sw = 0; sw < 16; ++sw) { const int ch = sw * 64 + rsub; f32x4 a, b; unpack8(*(const u32x4*)(gvt + (size_t)ch * LD_GVT + t0), a, b);
#pragma unroll
                    for (int j = 0; j < 4; ++j) { s[j] += a[j]; q[j] += a[j] * a[j]; s[4 + j] += b[j]; q[4 + j] += b[j] * b[j]; } }
#pragma unroll
                for (int j = 0; j < 8; ++j) { s[j] += __shfl_xor(s[j], 8); s[j] += __shfl_xor(s[j], 16); s[j] += __shfl_xor(s[j], 32); q[j] += __shfl_xor(q[j], 8); q[j] += __shfl_xor(q[j], 16); q[j] += __shfl_xor(q[j], 32); }
                if (lane < 8) {
#pragma unroll
                    for (int j = 0; j < 8; ++j) { red[(wave * 64 + 8 * c8 + j) * 2 + 0] = s[j]; red[(wave * 64 + 8 * c8 + j) * 2 + 1] = q[j]; } }
                __syncthreads();
                float mean[8], rstd[8];
#pragma unroll
                for (int j = 0; j < 8; ++j) { float ss = 0.f, qq = 0.f;
#pragma unroll
                    for (int w = 0; w < 8; ++w) { ss += red[(w * 64 + 8 * c8 + j) * 2 + 0]; qq += red[(w * 64 + 8 * c8 + j) * 2 + 1]; }
                    mean[j] = ss * (1.f / D); float var = qq * (1.f / D) - mean[j] * mean[j]; var = var > 0.f ? var : 0.f; rstd[j] = 1.0f / sqrtf(var + EPS); }
#pragma unroll 4
                for (int sw = 0; sw < 16; ++sw) { const int ch = sw * 64 + rsub; bf16_t* ptr = gvt + (size_t)ch * LD_GVT + t0; f32x4 a, b; unpack8(*(const u32x4*)ptr, a, b);
                    const float gs = p.g_sg[ch], bs = p.b_sg[ch];
#pragma unroll
                    for (int j = 0; j < 4; ++j) { a[j] = (a[j] - mean[j]) * rstd[j] * gs + bs; b[j] = (b[j] - mean[4 + j]) * rstd[4 + j] * gs + bs; }
                    *(u32x4*)ptr = pack8(a, b); }
                __syncthreads();
            }
        }
        {
            const bf16_t* qb = (const bf16_t*)(ws + WS_Q); bf16_t* ps = (bf16_t*)(ws + WS_PS); const float* lgt = (const float*)(ws + WS_LG);
            for (int e = gt; e < MS * 4 * 16; e += NGT) { const int dc = e & 15, h = (e >> 4) & 3, tok = e >> 6, b = tok >> 10, pos = tok & 1023;
                f32x4 q0, q1; unpack8(*(const u32x4*)(qb + (size_t)(MP + tok) * 512 + h * 128 + dc * 8), q0, q1);
                const float ff = exp2f(lgt[h] * (float)(pos + 1)), fb = exp2f(lgt[4 + h] * (float)(1024 - pos));
                bf16_t* dst = ps + ((size_t)((b * 4 + h) * 1024 + pos)) * 1280 + 1024 + dc * 8;
                *(u32x4*)dst = pack8(q0 * ff, q1 * ff); *(u32x4*)(dst + 128) = pack8(q0 * fb, q1 * fb); }
        }
        {
            bf16_t* vts = (bf16_t*)(ws + WS_VTS);
            for (int e = gt; e < 32 * 256 * 16; e += NGT) { const int ee = e & 255, dc = (e >> 8) & 15, bhd = e >> 12, dir = bhd & 1, bh = bhd >> 1;
                const float* src = (dir ? p.s0b : p.s0f) + ((size_t)bh * 128 + dc * 8) * 256 + ee;
                u32x4 o; o.x = cvt_pk_bf16(src[0], src[256]); o.y = cvt_pk_bf16(src[512], src[768]); o.z = cvt_pk_bf16(src[1024], src[1280]); o.w = cvt_pk_bf16(src[1536], src[1792]);
                *(u32x4*)(vts + ((size_t)((bh >> 2) * 1024 + (bh & 3) * 256 + ee)) * 1280 + 1024 + dir * 128 + dc * 8) = o; }
        }
#endif
    }
    SEAM(6);
    if (IN(7)) { LOADP;  SchedMix S{ws, G, bid}; Epi<7> E{p, xl}; gemm_phase(lds, S, E); }
    SEAM(7);
    if (IN(8)) { LOADP;
        {   const bool spare = G > 192; const int cgw = spare ? (bid - 192) * 8 + wave : gw, cng = spare ? (G - 192) * 8 : NGW;
            if (!spare || bid >= 192) {
                conv_matrix<1>(p.w_ffn2_in, D, 2 * FF, (bf16_t*)(ws + WS_W3), scr, cgw, cng, lane);
                conv_matrix<0>(p.w_ffn2_out, FF, D, (bf16_t*)(ws + WS_W4), scr, cgw, cng, lane);
                __syncthreads(); } }
        SchedMerge S{ws, G, bid}; Epi<8> E{p, xl}; gemm_phase(lds, S, E);
    }
    SEAM(8);
    if (IN(9)) { LOADP;  SchedT192 S{(const char*)(ws + WS_MERGED), (const char*)(ws + WS_WO), 2048, 2048, 16, G, bid}; Epi<9> E{p, xl}; gemm_phase<Epi<9>, SchedT192, true>(lds, S, E); }
    SEAM(9);
    if (IN(11)) { LOADP;  SchedSwiglu S{(const char*)(ws + WS_H3), (const char*)(ws + WS_W3), G, bid}; Epi<2> E{p, xl}; gemm_phase<Epi<2>, SchedSwiglu, false, true>(lds, S, E); }
    SEAM(11);
    if (IN(12)) { LOADP;  SchedT192 S{(const char*)(ws + WS_ACT), (const char*)(ws + WS_W4), FF * 2, FF * 2, 44, G, bid}; Epi<12> E{p, xl}; gemm_phase<Epi<12>, SchedT192, true>(lds, S, E); }
#undef IN
#undef SEAM
}

#ifndef RUN_MASK
#define RUN_MASK 0x3fff
#endif
#ifndef MK_N_LAUNCHES
#define MK_N_LAUNCHES 1
#endif
extern "C" void kernel_launch(void* const* d_in, const int* in_sizes, int n_in, void* d_out, int out_size, void* d_ws, size_t ws_size, hipStream_t stream) {
    static int grid = 0;
    if (grid == 0) {
        if (n_in != 23 || ws_size < WS_END) { fprintf(stderr, "kernel_launch: unexpected inputs (n_in %d, ws %zu)\n", n_in, ws_size); grid = -1; return; }
        int dev = 0, cus = 0, per_cu = 0;
        if (hipGetDevice(&dev) != hipSuccess || hipDeviceGetAttribute(&cus, hipDeviceAttributeMultiprocessorCount, dev) != hipSuccess) { grid = -1; return; }
        if (hipFuncSetAttribute((const void*)fwd_kernel, hipFuncAttributeMaxDynamicSharedMemorySize, LDS_BYTES) != hipSuccess) { fprintf(stderr, "kernel_launch: hipFuncSetAttribute failed\n"); grid = -1; return; }
        if (hipOccupancyMaxActiveBlocksPerMultiprocessor(&per_cu, (const void*)fwd_kernel, 512, LDS_BYTES) != hipSuccess || per_cu < 1) { fprintf(stderr, "kernel_launch: occupancy query says %d\n", per_cu); per_cu = 1; }
        (void)hipGetLastError();
        grid = cus;
    }
    if (grid < 0) return;
    Params p{};
    p.x_prompt = (const float*)d_in[0]; p.x_sample = (const float*)d_in[1]; p.s0f = (const float*)d_in[2]; p.s0b = (const float*)d_in[3]; p.c = (const float*)d_in[4]; p.c_ctx = (const float*)d_in[5];
    p.w_ada = (const float*)d_in[6]; p.b_ada = (const float*)d_in[7]; p.g_norm = (const float*)d_in[8]; p.w_ffn1_in = (const float*)d_in[9]; p.w_ffn1_out = (const float*)d_in[10]; p.w_in = (const float*)d_in[11];
    p.decay = (const float*)d_in[12]; p.g_ret = (const float*)d_in[13]; p.w_ret_br = (const float*)d_in[14]; p.g_sg = (const float*)d_in[15]; p.b_sg = (const float*)d_in[16]; p.w_sp = (const float*)d_in[17]; p.b_sp = (const float*)d_in[18];
    p.w_sg_br = (const float*)d_in[19]; p.w_out = (const float*)d_in[20]; p.w_ffn2_in = (const float*)d_in[21]; p.w_ffn2_out = (const float*)d_in[22];
    p.out = (float*)d_out; p.ws = (unsigned char*)d_ws;
#if MK_N_LAUNCHES == 1
    (void)hipMemsetAsync((char*)d_ws + WS_BAR, 0, 65536, stream);
    p.ph_lo = RUN_MASK; p.ph_hi = 1;
    void* args[] = {&p};
    hipError_t e = hipLaunchCooperativeKernel((const void*)fwd_kernel, dim3(grid), dim3(512), args, LDS_BYTES, stream);
    if (e != hipSuccess) fprintf(stderr, "kernel_launch: cooperative launch failed: %s (grid %d)\n", hipGetErrorString(e), grid);
#else
    for (int ph = 0; ph < 14; ++ph) { p.ph_lo = 1 << ph; p.ph_hi = 0; hipLaunchKernelGGL(fwd_kernel, dim3(grid), dim3(512), LDS_BYTES, stream, p); }
#endif
}
```
